# Optimizing an MI355X kernel written in HIP

```python
import math
import jax
import jax.numpy as jnp
from jax import lax
import numpy as np

D_MODEL = 1024
BATCH = 2
SEQ = 8192
DEPTH = 2

CTX_LEN = 256
GRID_W = 64
N_MOD = 6
EPS = 1e-6
ATTN_W = D_MODEL // 2
ATTN_HD = 64
ATTN_VD = 2 * ATTN_HD
ATTN_HEADS = ATTN_W // ATTN_VD
Q_BLOCK = 128
ROPE_BASE = 10000.0
SSM_W = D_MODEL // 4
SSM_GROUP = 16
SSM_GROUPS = SSM_W // SSM_GROUP
SSM_STATE = 64
POOL_W = D_MODEL // 4
POOL_WINDOWS = (2, 4, 8, 16)
POOL_GROUP = POOL_W // len(POOL_WINDOWS)
MIX_W = ATTN_W + SSM_W + POOL_W
SSM_OFF = 3 * ATTN_W
POOL_OFF = SSM_OFF + SSM_W
IN_W = POOL_OFF + POOL_W
PEER_HEADS = 8
PEER_NKEYS = 128
PEER_EXPERTS = PEER_NKEYS * PEER_NKEYS
PEER_QDIM = 256
PEER_KDIM = PEER_QDIM // 2
PEER_TOPK = 16
PEER_CHUNK = 128

kernel_name = 'hybrid_diffattn_s5_pool_peer_block'


def rmsnorm(x, g):
    xf = x.astype(jnp.float32)
    y = xf * lax.rsqrt(jnp.mean(xf * xf, axis=-1, keepdims=True) + EPS)
    return (y * g.astype(jnp.float32)).astype(x.dtype)


def modulate(h, shift, scale):
    return h * (1.0 + scale) + shift


def axial_rope_tables(rows):
    r = jnp.repeat(jnp.arange(rows), GRID_W)
    col = jnp.tile(jnp.arange(GRID_W), rows)
    pos = jnp.stack([r, col], axis=-1).astype(jnp.float32)
    nf = ATTN_HD // 4
    inv = 1.0 / (ROPE_BASE ** (jnp.arange(nf, dtype=jnp.float32) / nf))
    ang = pos[:, :, None] * inv
    return jnp.cos(ang), jnp.sin(ang)


def apply_rope(x, cos, sin):
    nf = x.shape[-1] // 4
    xr = x.reshape(x.shape[:-1] + (2, 2, nf))
    x1 = xr[..., 0, :]
    x2 = xr[..., 1, :]
    cb = cos[:, None, None]
    sb = sin[:, None, None]
    out = jnp.stack([x1 * cb - x2 * sb, x2 * cb + x1 * sb], axis=-2)
    return out.reshape(x.shape).astype(x.dtype)


def split_qkv(p):
    B, L = p.shape[0], p.shape[1]
    q = p[..., :ATTN_W].reshape(B, L, ATTN_HEADS, 2, ATTN_HD)
    k = p[..., ATTN_W:2 * ATTN_W].reshape(B, L, ATTN_HEADS, 2, ATTN_HD)
    v = p[..., 2 * ATTN_W:SSM_OFF].reshape(B, L, ATTN_HEADS, ATTN_VD)
    return q, k, v


def diff_attend(q, k, v, lam):
    s = jnp.einsum('bqhsd,bkhsd->bhsqk', q, k).astype(jnp.float32)
    p = jax.nn.softmax(s, axis=-1)
    a = (p[:, :, 0] - lam * p[:, :, 1]).astype(v.dtype)
    return jnp.einsum('bhqk,bkhe->bqhe', a, v)


def diff_attn_latent(q, k, v, kc, vc, lam, cos, sin):
    B, L = q.shape[0], q.shape[1]
    q = apply_rope(q, cos, sin) * (ATTN_HD ** -0.5)
    k_all = jnp.concatenate([apply_rope(k, cos, sin), kc], axis=1)
    v_all = jnp.concatenate([v, vc], axis=1)
    nb = L // Q_BLOCK
    qb = jnp.moveaxis(q.reshape((B, nb, Q_BLOCK) + q.shape[2:]), 1, 0)
    o = lax.map(lambda qi: diff_attend(qi, k_all, v_all, lam), qb)
    return jnp.moveaxis(o, 0, 1).reshape(B, L, ATTN_HEADS, ATTN_VD)


def attn_head_out(o, g, lam_init):
    B, L = o.shape[0], o.shape[1]
    return (rmsnorm(o, g) * (1.0 - lam_init)).reshape(B, L, ATTN_W)


def zoh_discretise(lre, lim, log_step, bre, bim):
    step = jnp.exp(log_step)[:, None]
    er = jnp.exp(lre * step)
    ar = er * jnp.cos(lim * step)
    ai = er * jnp.sin(lim * step)
    nr = ar - 1.0
    den = lre * lre + lim * lim
    cr = (nr * lre + ai * lim) / den
    ci = (ai * lre - nr * lim) / den
    bbr = cr[..., None] * bre - ci[..., None] * bim
    bbi = cr[..., None] * bim + ci[..., None] * bre
    return ar, ai, bbr, bbi


def complex_affine_combine(e1, e2):
    a1r, a1i, b1r, b1i = e1
    a2r, a2i, b2r, b2i = e2
    return (a2r * a1r - a2i * a1i, a2r * a1i + a2i * a1r,
            a2r * b1r - a2i * b1i + b2r, a2r * b1i + a2i * b1r + b2i)


def ssm_scan(u, ar, ai, bbr, bbi, cr, ci, h0r, h0i, reverse, with_output):
    if reverse:
        u = jnp.flip(u, axis=1)
    bur = jnp.einsum('gph,blgh->blgp', bbr, u)
    bui = jnp.einsum('gph,blgh->blgp', bbi, u)
    bur = bur.at[:, 0].add(ar * h0r - ai * h0i)
    bui = bui.at[:, 0].add(ar * h0i + ai * h0r)
    a_r = jnp.broadcast_to(ar, bur.shape)
    a_i = jnp.broadcast_to(ai, bui.shape)
    _, _, hr, hi = lax.associative_scan(complex_affine_combine, (a_r, a_i, bur, bui), axis=1)
    last = (hr[:, -1], hi[:, -1])
    if not with_output:
        return None, last
    y = jnp.einsum('ghp,blgp->blgh', cr, hr) - jnp.einsum('ghp,blgp->blgh', ci, hi)
    if reverse:
        y = jnp.flip(y, axis=1)
    return y, last


def s5_glu(y, w_glu):
    B, L = y.shape[0], y.shape[1]
    yg = jax.nn.gelu(y.reshape(B, L, SSM_W), approximate=False)
    return yg * jax.nn.sigmoid(yg @ w_glu.astype(jnp.float32))


def s5_mixer(u_lat, u_ctx, lam_re, lam_im, log_step, b_re, b_im, c_re, c_im, d, w_glu, ctx_out):
    f32 = jnp.float32
    B, L = u_lat.shape[0], u_lat.shape[1]
    Lc = u_ctx.shape[1]
    ul = u_lat.astype(f32).reshape(B, L, SSM_GROUPS, SSM_GROUP)
    uc = u_ctx.astype(f32).reshape(B, Lc, SSM_GROUPS, SSM_GROUP)
    dg = d.astype(f32).reshape(SSM_GROUPS, SSM_GROUP)
    y_lat = dg * ul
    y_ctx = dg * uc if ctx_out else None
    zero = jnp.zeros((B, SSM_GROUPS, SSM_STATE), f32)
    for dr in range(2):
        rev = dr == 1
        ar, ai, bbr, bbi = zoh_discretise(lam_re[dr].astype(f32), lam_im[dr].astype(f32),
                                          log_step[dr].astype(f32), b_re[dr].astype(f32), b_im[dr].astype(f32))
        cr = c_re[dr].astype(f32)
        ci = c_im[dr].astype(f32)
        yc, (hcr, hci) = ssm_scan(uc, ar, ai, bbr, bbi, cr, ci, zero, zero, rev, ctx_out)
        yl, _ = ssm_scan(ul, ar, ai, bbr, bbi, cr, ci, hcr, hci, rev, True)
        y_lat = y_lat + yl
        if ctx_out:
            y_ctx = y_ctx + yc
    out_lat = s5_glu(y_lat, w_glu).astype(u_lat.dtype)
    if not ctx_out:
        return out_lat, None
    return out_lat, s5_glu(y_ctx, w_glu).astype(u_ctx.dtype)


def pool_mix(u, w, scale):
    B, L = u.shape[0], u.shape[1]
    uf = u.astype(jnp.float32)
    csum = jnp.concatenate([jnp.zeros((B, 1, POOL_W), jnp.float32), jnp.cumsum(uf, axis=1)], axis=1)
    t = jnp.arange(L)
    outs = []
    for gi, win in enumerate(POOL_WINDOWS):
        sl = slice(gi * POOL_GROUP, (gi + 1) * POOL_GROUP)
        lo = jnp.clip(t - win // 2, 0, L)
        hi = jnp.clip(t + win // 2, 0, L)
        cg = csum[..., sl]
        mean = (jnp.take(cg, hi, axis=1) - jnp.take(cg, lo, axis=1)) / (hi - lo).astype(jnp.float32)[:, None]
        outs.append(jnp.einsum('blc,ce->ble', mean - uf[..., sl], w[gi].astype(jnp.float32)))
    return (jnp.concatenate(outs, axis=-1) * scale.astype(jnp.float32)).astype(u.dtype)


def peer_ffn(h, wq, keys, U, V):
    shp = h.shape
    x = h.reshape(-1, shp[-1])
    T = x.shape[0]
    q = (x @ wq).reshape(T, PEER_HEADS, 2, PEER_KDIM)
    s = jnp.einsum('thcd,hcnd->thcn', q, keys).astype(jnp.float32)
    s1, i1 = lax.top_k(s[:, :, 0], PEER_TOPK)
    s2, i2 = lax.top_k(s[:, :, 1], PEER_TOPK)
    cs = (s1[..., :, None] + s2[..., None, :]).reshape(T, PEER_HEADS, PEER_TOPK * PEER_TOPK)
    cidx = (i1[..., :, None] * PEER_NKEYS + i2[..., None, :]).reshape(T, PEER_HEADS, PEER_TOPK * PEER_TOPK)
    best, pos = lax.top_k(cs, PEER_TOPK)
    idx = jnp.take_along_axis(cidx, pos, axis=-1)
    g = jax.nn.softmax(best, axis=-1).astype(h.dtype)
    nc = T // PEER_CHUNK

    def chunk(args):
        xc, ic, gc = args
        a = jax.nn.gelu(jnp.einsum('cd,chkd->chk', xc, U[ic]), approximate=False) * gc
        return jnp.einsum('chk,chkd->cd', a, V[ic])

    y = lax.map(chunk, (x.reshape(nc, PEER_CHUNK, shp[-1]),
                        idx.reshape(nc, PEER_CHUNK, PEER_HEADS, PEER_TOPK),
                        g.reshape(nc, PEER_CHUNK, PEER_HEADS, PEER_TOPK)))
    return y.reshape(shp)


def setup_inputs(seed: int = 0) -> dict:
    key = jax.random.key(seed)
    ks = jax.random.split(key, 32)
    f = jnp.float32
    D = D_MODEL
    G, P, H = SSM_GROUPS, SSM_STATE, SSM_GROUP

    def nrm(k, shape, s):
        return jax.random.normal(k, shape, f) * s

    n_idx = jnp.arange(P, dtype=f)
    return {
        'x': nrm(ks[0], (BATCH, SEQ, D), 1.0),
        'c': nrm(ks[1], (BATCH, D), 1.0),
        'ctx': nrm(ks[2], (BATCH, CTX_LEN, D), 1.0),
        'c_ctx': nrm(ks[3], (D,), 1.0),
        'w_mod': nrm(ks[4], (DEPTH, D, N_MOD * D), 0.5 * D ** -0.5),
        'b_mod': nrm(ks[5], (DEPTH, N_MOD * D), 0.01),
        'norm1_g': 1.0 + nrm(ks[6], (DEPTH, D), 0.01),
        'norm2_g': 1.0 + nrm(ks[7], (DEPTH, D), 0.01),
        'w_in': nrm(ks[8], (DEPTH, D, IN_W), D ** -0.5),
        'w_out': nrm(ks[9], (DEPTH, MIX_W, D), MIX_W ** -0.5),
        'lam_q1': nrm(ks[10], (DEPTH, ATTN_HD), 0.1),
        'lam_k1': nrm(ks[11], (DEPTH, ATTN_HD), 0.1),
        'lam_q2': nrm(ks[12], (DEPTH, ATTN_HD), 0.1),
        'lam_k2': nrm(ks[13], (DEPTH, ATTN_HD), 0.1),
        'subln_g': 1.0 + nrm(ks[14], (DEPTH, ATTN_VD), 0.01),
        'ssm_lambda_re': -0.5 + nrm(ks[15], (DEPTH, 2, G, P), 0.01),
        'ssm_lambda_im': math.pi * n_idx + nrm(ks[16], (DEPTH, 2, G, P), 0.01),
        'ssm_log_step': jax.random.uniform(ks[17], (DEPTH, 2, G), f, math.log(1e-3), math.log(1e-1)),
        'ssm_b_re': nrm(ks[18], (DEPTH, 2, G, P, H), (2 * H) ** -0.5),
        'ssm_b_im': nrm(ks[19], (DEPTH, 2, G, P, H), (2 * H) ** -0.5),
        'ssm_c_re': nrm(ks[20], (DEPTH, 2, G, H, P), P ** -0.5),
        'ssm_c_im': nrm(ks[21], (DEPTH, 2, G, H, P), P ** -0.5),
        'ssm_d': nrm(ks[22], (DEPTH, SSM_W), 1.0),
        'ssm_w_glu': nrm(ks[23], (DEPTH, SSM_W, SSM_W), SSM_W ** -0.5),
        'pool_w': nrm(ks[24], (DEPTH, len(POOL_WINDOWS), POOL_GROUP, POOL_GROUP), POOL_GROUP ** -0.5),
        'pool_scale': 1.0 + nrm(ks[25], (DEPTH, POOL_W), 0.1),
        'peer_wq': nrm(ks[26], (DEPTH, D, PEER_HEADS * PEER_QDIM), D ** -0.5),
        'peer_keys': nrm(ks[27], (DEPTH, PEER_HEADS, 2, PEER_NKEYS, PEER_KDIM), PEER_KDIM ** -0.5),
        'peer_u': nrm(ks[28], (DEPTH, PEER_EXPERTS, D), D ** -0.5),
        'peer_v': nrm(ks[29], (DEPTH, PEER_EXPERTS, D), 0.5),
        'final_g': 1.0 + nrm(ks[30], (D,), 0.01),
    }


def reference(x, c, ctx, c_ctx, w_mod, b_mod, norm1_g, norm2_g, w_in, w_out,
              lam_q1, lam_k1, lam_q2, lam_k2, subln_g,
              ssm_lambda_re, ssm_lambda_im, ssm_log_step, ssm_b_re, ssm_b_im, ssm_c_re, ssm_c_im,
              ssm_d, ssm_w_glu, pool_w, pool_scale, peer_wq, peer_keys, peer_u, peer_v, final_g):
    B, L, D = x.shape
    rows = L // GRID_W
    cos, sin = axial_rope_tables(rows)
    sc = jax.nn.silu(c)
    scc = jax.nn.silu(c_ctx)
    xc = ctx
    for l in range(DEPTH):
        last = l == DEPTH - 1
        mod = (sc @ w_mod[l] + b_mod[l]).reshape(B, N_MOD, 1, D)
        modc = (scc @ w_mod[l] + b_mod[l]).reshape(N_MOD, D)
        h = modulate(rmsnorm(x, norm1_g[l]), mod[:, 0], mod[:, 1])
        hc = modulate(rmsnorm(xc, norm1_g[l]), modc[0], modc[1])
        pl = h @ w_in[l]
        pc = hc @ w_in[l]
        lam_init = 0.8 - 0.6 * math.exp(-0.3 * l)
        lam = (jnp.exp(jnp.sum(lam_q1[l].astype(jnp.float32) * lam_k1[l].astype(jnp.float32)))
               - jnp.exp(jnp.sum(lam_q2[l].astype(jnp.float32) * lam_k2[l].astype(jnp.float32)))
               + lam_init)
        ql, kl, vl = split_qkv(pl)
        qc, kc, vc = split_qkv(pc)
        attn_l = attn_head_out(diff_attn_latent(ql, kl, vl, kc, vc, lam, cos, sin), subln_g[l], lam_init)
        ssm_l, ssm_c = s5_mixer(pl[..., SSM_OFF:POOL_OFF], pc[..., SSM_OFF:POOL_OFF],
                                ssm_lambda_re[l], ssm_lambda_im[l], ssm_log_step[l],
                                ssm_b_re[l], ssm_b_im[l], ssm_c_re[l], ssm_c_im[l],
                                ssm_d[l], ssm_w_glu[l], not last)
        pool_l = pool_mix(pl[..., POOL_OFF:], pool_w[l], pool_scale[l])
        x = x + mod[:, 2] * (jnp.concatenate([attn_l, ssm_l, pool_l], axis=-1) @ w_out[l])
        if not last:
            attn_c = attn_head_out(diff_attend(qc * (ATTN_HD ** -0.5), kc, vc, lam), subln_g[l], lam_init)
            pool_c = pool_mix(pc[..., POOL_OFF:], pool_w[l], pool_scale[l])
            xc = xc + modc[2] * (jnp.concatenate([attn_c, ssm_c, pool_c], axis=-1) @ w_out[l])
        h = modulate(rmsnorm(x, norm2_g[l]), mod[:, 3], mod[:, 4])
        x = x + mod[:, 5] * peer_ffn(h, peer_wq[l], peer_keys[l], peer_u[l], peer_v[l])
        if not last:
            hc = modulate(rmsnorm(xc, norm2_g[l]), modc[3], modc[4])
            xc = xc + modc[5] * peer_ffn(hc, peer_wq[l], peer_keys[l], peer_u[l], peer_v[l])
    return rmsnorm(x, final_g)
```

```cpp
#include <hip/hip_runtime.h>
#include <cstdio>
#include <cstdint>
#include <cmath>
#include <hip/hip_cooperative_groups.h>
namespace cg = cooperative_groups;
typedef unsigned short bf16_t;

constexpr int D = 1024, BATCH = 2, SEQ = 8192, DEPTH = 2, CTX = 256, GRIDW = 64;
constexpr int RL = BATCH * SEQ;
constexpr int RC = BATCH * CTX;
constexpr int R = RL + RC;
constexpr int NMOD = 6;
constexpr int ATTN_W = 512, HD = 64, VD = 128, NH = 4;
constexpr int SSM_W = 256, SG = 16, NG = 16, PS = 64;
constexpr int POOL_W = 256;
constexpr int SSM_OFF = 1536, POOL_OFF = 1792, IN_W = 2048;
constexpr int PH = 8, NK = 128, QD = 256, KD = 128, TOPK = 16;
constexpr float EPS = 1e-6f;

constexpr size_t ws_al(size_t x) { return (x + 255) / 256 * 256; }
constexpr size_t OFF_ctl = 0;
constexpr size_t CTL_BYTES = 16384;
constexpr size_t OFF_mod = OFF_ctl + CTL_BYTES;
constexpr size_t OFF_sp_n1g = OFF_mod + ws_al((size_t)DEPTH*3*NMOD*D*4);
constexpr size_t OFF_sp_n2g = OFF_sp_n1g + ws_al((size_t)DEPTH*D*4);
constexpr size_t OFF_sp_fing = OFF_sp_n2g + ws_al((size_t)DEPTH*D*4);
constexpr size_t OFF_sp_lam = OFF_sp_fing + ws_al((size_t)D*4);
constexpr size_t OFF_sp_subln = OFF_sp_lam + ws_al(256);
constexpr size_t OFF_sp_ssmd = OFF_sp_subln + ws_al((size_t)DEPTH*VD*4);
constexpr size_t OFF_sp_poolsc = OFF_sp_ssmd + ws_al((size_t)DEPTH*SSM_W*4);
constexpr size_t OFF_sp_a64 = OFF_sp_poolsc + ws_al((size_t)DEPTH*POOL_W*4);
constexpr size_t OFF_ropet = OFF_sp_a64 + ws_al((size_t)64*64*2*4);
constexpr size_t OFF_w_in_t = OFF_ropet + ws_al((size_t)SEQ*32*2*4);
constexpr size_t OFF_w_out_t = OFF_w_in_t + ws_al((size_t)DEPTH*IN_W*D*2);
constexpr size_t OFF_wq_t = OFF_w_out_t + ws_al((size_t)DEPTH*D*D*2);
constexpr size_t OFF_wglu_t = OFF_wq_t + ws_al((size_t)DEPTH*PH*QD*D*2);
constexpr size_t OFF_poolw_t = OFF_wglu_t + ws_al((size_t)DEPTH*SSM_W*SSM_W*2);
constexpr size_t OFF_keysb = OFF_poolw_t + ws_al((size_t)DEPTH*4*64*64*2);
constexpr size_t OFF_ssm_km = OFF_keysb + ws_al((size_t)DEPTH*PH*2*NK*KD*2);
constexpr size_t OFF_ssm_we = OFF_ssm_km + ws_al((size_t)64*64*256*2);
constexpr size_t OFF_ssm_wc = OFF_ssm_we + ws_al((size_t)64*128*1024*2);
constexpr size_t OFF_u16 = OFF_ssm_wc + ws_al((size_t)64*1024*128*2);
constexpr size_t OFF_v16 = OFF_u16 + ws_al((size_t)DEPTH*NK*NK*D);
constexpr size_t OFF_xb = OFF_v16 + ws_al((size_t)DEPTH*NK*NK*D);
constexpr size_t OFF_qb = OFF_xb + ws_al((size_t)R*D*4);
constexpr size_t OFF_kb = OFF_qb + ws_al((size_t)R*512*2);
constexpr size_t OFF_vb = OFF_kb + ws_al((size_t)R*512*2);
constexpr size_t OFF_ub = OFF_vb + ws_al((size_t)R*512*2);
constexpr size_t OFF_pb = OFF_ub + ws_al((size_t)R*256*2);
constexpr size_t OFF_mixb = OFF_pb + ws_al((size_t)R*256*2);
constexpr size_t OFF_yc = OFF_mixb + ws_al((size_t)R*D*2);
constexpr size_t OFF_hb = OFF_yc + ws_al((size_t)2*R*SSM_W*4);
constexpr size_t OFF_qpb = OFF_mixb;
constexpr size_t WS_TOTAL = OFF_hb + ws_al((size_t)R*D*2);
static_assert(OFF_mod == OFF_ctl + CTL_BYTES, "mod follows the barrier words (one memset)");
static_assert(OFF_kb == OFF_qb + (size_t)R*512*2 && OFF_vb == OFF_qb + (size_t)2*R*512*2 && OFF_ub == OFF_qb + (size_t)3*R*512*2 && OFF_pb == OFF_ub + (size_t)R*256*2, "in-proj outputs must be contiguous (EpiInProj)");
static_assert(OFF_yc == OFF_mixb + (size_t)R*D*2 && (size_t)R*PH*QD*2 <= (size_t)R*D*2 + (size_t)2*R*SSM_W*4, "qpb overlays mixb|yc");
struct P {
    const float* in[31]; float* out_; unsigned char* ws;
    __host__ __device__ __forceinline__ float* out() const { return out_; }
    __host__ __device__ __forceinline__ unsigned* ctl() const { return (unsigned*)(ws + OFF_ctl); }
    __host__ __device__ __forceinline__ const float* x() const { return in[0]; }
    __host__ __device__ __forceinline__ const float* c() const { return in[1]; }
    __host__ __device__ __forceinline__ const float* ctx() const { return in[2]; }
    __host__ __device__ __forceinline__ const float* c_ctx() const { return in[3]; }
    __host__ __device__ __forceinline__ const float* w_mod() const { return in[4]; }
    __host__ __device__ __forceinline__ const float* b_mod() const { return in[5]; }
    __host__ __device__ __forceinline__ const float* norm1_g() const { return in[6]; }
    __host__ __device__ __forceinline__ const float* norm2_g() const { return in[7]; }
    __host__ __device__ __forceinline__ const float* w_in() const { return in[8]; }
    __host__ __device__ __forceinline__ const float* w_out() const { return in[9]; }
    __host__ __device__ __forceinline__ const float* lam_q1() const { return in[10]; }
    __host__ __device__ __forceinline__ const float* lam_k1() const { return in[11]; }
    __host__ __device__ __forceinline__ const float* lam_q2() const { return in[12]; }
    __host__ __device__ __forceinline__ const float* lam_k2() const { return in[13]; }
    __host__ __device__ __forceinline__ const float* subln_g() const { return in[14]; }
    __host__ __device__ __forceinline__ const float* lre() const { return in[15]; }
    __host__ __device__ __forceinline__ const float* lim() const { return in[16]; }
    __host__ __device__ __forceinline__ const float* lstep() const { return in[17]; }
    __host__ __device__ __forceinline__ const float* bre() const { return in[18]; }
    __host__ __device__ __forceinline__ const float* bim() const { return in[19]; }
    __host__ __device__ __forceinline__ const float* cre() const { return in[20]; }
    __host__ __device__ __forceinline__ const float* cim() const { return in[21]; }
    __host__ __device__ __forceinline__ const float* ssm_d() const { return in[22]; }
    __host__ __device__ __forceinline__ const float* w_glu() const { return in[23]; }
    __host__ __device__ __forceinline__ const float* pool_w() const { return in[24]; }
    __host__ __device__ __forceinline__ const float* pool_scale() const { return in[25]; }
    __host__ __device__ __forceinline__ const float* wq() const { return in[26]; }
    __host__ __device__ __forceinline__ const float* keys() const { return in[27]; }
    __host__ __device__ __forceinline__ const float* pu() const { return in[28]; }
    __host__ __device__ __forceinline__ const float* pv() const { return in[29]; }
    __host__ __device__ __forceinline__ const float* final_g() const { return in[30]; }
    __host__ __device__ __forceinline__ float* mod() const { return (float*)(ws + OFF_mod); }
    __host__ __device__ __forceinline__ float* sp_n1g() const { return (float*)(ws + OFF_sp_n1g); }
    __host__ __device__ __forceinline__ float* sp_n2g() const { return (float*)(ws + OFF_sp_n2g); }
    __host__ __device__ __forceinline__ float* sp_fing() const { return (float*)(ws + OFF_sp_fing); }
    __host__ __device__ __forceinline__ float* sp_lam() const { return (float*)(ws + OFF_sp_lam); }
    __host__ __device__ __forceinline__ float* sp_subln() const { return (float*)(ws + OFF_sp_subln); }
    __host__ __device__ __forceinline__ float* sp_ssmd() const { return (float*)(ws + OFF_sp_ssmd); }
    __host__ __device__ __forceinline__ float* sp_poolsc() const { return (float*)(ws + OFF_sp_poolsc); }
    __host__ __device__ __forceinline__ float* sp_a64() const { return (float*)(ws + OFF_sp_a64); }
    __host__ __device__ __forceinline__ float* ropet() const { return (float*)(ws + OFF_ropet); }
    __host__ __device__ __forceinline__ bf16_t* w_in_t() const { return (bf16_t*)(ws + OFF_w_in_t); }
    __host__ __device__ __forceinline__ bf16_t* w_out_t() const { return (bf16_t*)(ws + OFF_w_out_t); }
    __host__ __device__ __forceinline__ bf16_t* wq_t() const { return (bf16_t*)(ws + OFF_wq_t); }
    __host__ __device__ __forceinline__ bf16_t* wglu_t() const { return (bf16_t*)(ws + OFF_wglu_t); }
    __host__ __device__ __forceinline__ bf16_t* poolw_t() const { return (bf16_t*)(ws + OFF_poolw_t); }
    __host__ __device__ __forceinline__ bf16_t* keysb() const { return (bf16_t*)(ws + OFF_keysb); }
    __host__ __device__ __forceinline__ bf16_t* ssm_km() const { return (bf16_t*)(ws + OFF_ssm_km); }
    __host__ __device__ __forceinline__ bf16_t* ssm_we() const { return (bf16_t*)(ws + OFF_ssm_we); }
    __host__ __device__ __forceinline__ bf16_t* ssm_wc() const { return (bf16_t*)(ws + OFF_ssm_wc); }
    __host__ __device__ __forceinline__ unsigned char* u8() const { return (unsigned char*)(ws + OFF_u16); }
    __host__ __device__ __forceinline__ unsigned char* v8() const { return (unsigned char*)(ws + OFF_v16); }
    __host__ __device__ __forceinline__ float* xb() const { return (float*)(ws + OFF_xb); }
    __host__ __device__ __forceinline__ bf16_t* qb() const { return (bf16_t*)(ws + OFF_qb); }
    __host__ __device__ __forceinline__ bf16_t* kb() const { return (bf16_t*)(ws + OFF_kb); }
    __host__ __device__ __forceinline__ bf16_t* vb() const { return (bf16_t*)(ws + OFF_vb); }
    __host__ __device__ __forceinline__ bf16_t* ub() const { return (bf16_t*)(ws + OFF_ub); }
    __host__ __device__ __forceinline__ bf16_t* pb() const { return (bf16_t*)(ws + OFF_pb); }
    __host__ __device__ __forceinline__ bf16_t* mixb() const { return (bf16_t*)(ws + OFF_mixb); }
    __host__ __device__ __forceinline__ float* yc() const { return (float*)(ws + OFF_yc); }
    __host__ __device__ __forceinline__ bf16_t* hb() const { return (bf16_t*)(ws + OFF_hb); }
    __host__ __device__ __forceinline__ bf16_t* qpb() const { return (bf16_t*)(ws + OFF_qpb); }
};

__device__ __forceinline__ int modset(int row) { return row < RL ? row / SEQ : 2; }
__device__ __forceinline__ float gelu_exact(float v) { return 0.5f * v * (1.0f + erff(v * 0.70710678118654752f)); }
__device__ __forceinline__ float wave_sum(float v) {
#pragma unroll
    for (int o = 32; o > 0; o >>= 1) v += __shfl_xor(v, o);
    return v;
}

__device__ __forceinline__ int opaque_tid() { int t = threadIdx.x; asm volatile("" : "+v"(t)); return t; }

namespace pg8 {
#define PG8_LAS __attribute__((address_space(3)))
typedef unsigned short bf16_t;
typedef short bf16x8 __attribute__((ext_vector_type(8)));
typedef float f32x4 __attribute__((ext_vector_type(4)));
typedef unsigned u32x4 __attribute__((ext_vector_type(4)));
constexpr int BM = 256, BK = 64, HALF = 128, HTB = HALF * BK * 2  , STAGE_BYTES = 8 * HTB, NXCD = 8, WGM = 8;

__host__ __device__ __forceinline__ int lds_byte(int r, int c) { const int st = (r >> 4) * 2 + (c >> 5), rr = r & 15, cc = c & 31, ob = rr * 64 + cc * 2; return st * 1024 + (ob ^ (((ob >> 9) & 1) << 5)); }
__host__ __device__ __forceinline__ void stage_rc(int b, int& R, int& C) { const int st = b / 1024, sb = b % 1024, swz = sb ^ (((sb >> 9) & 1) << 5); R = (st >> 1) * 16 + swz / 64; C = (st & 1) * 32 + (swz % 64) / 2; }
__host__ __device__ __forceinline__ int perm32(int rho) { const int n = rho >> 4, i = rho & 15; return 8 * (i >> 2) + 4 * n + (i & 3); }

struct Unit { int pm, pn; };
struct Gemm { const bf16_t* A; const bf16_t* Bt; int M, N, K; };

struct StaticOrder {
    int nM, nN, nwg, G, c;
    __host__ __device__ void init(int M, int N, int G_, int c_) { nM = M / BM; nN = N / BM; nwg = nM * nN; G = G_; c = c_; }
    __host__ __device__ bool next(int i, Unit& u) const {
        const long L = (long)i * G + c; if (L >= nwg) return false;
        int wgid = (int)L; { const int q = nwg / NXCD, r = nwg % NXCD, xcd = wgid % NXCD, off = wgid / NXCD; wgid = (xcd < r ? xcd * (q + 1) : r * (q + 1) + (xcd - r) * q) + off; }
        const int nig = WGM * nN, gid = wgid / nig, fm = gid * WGM, gsz = (nM - fm) < WGM ? (nM - fm) : WGM;
        u.pm = fm + ((wgid % nig) % gsz); u.pn = (wgid % nig) / gsz; return true;
    }
    __device__ __forceinline__ void a_ready(const Unit&) const {}
    __device__ __forceinline__ void done(const Unit&) const {}
};

struct InProjOrder {
    int G, c; unsigned* cnt;
    __host__ __device__ static int n_ssm_wg(int G) { return G >= 128 ? 64 : 0; }
    __host__ __device__ bool next(int i, Unit& u) const {
        if (G == 256) {
            const int x = c & 7, s = c >> 3, npm = 8 + (x < 2 ? 1 : 0);
            int idx;
            if (i == 0) idx = s; else if (s >= 24) return false; else if (i == 1) idx = 32 + s; else if (i == 2) idx = 56 + s; else return false;
            if (idx >= npm * 8) return false;
            if (idx < npm) { u.pm = idx < 8 ? x * 8 + idx : 64 + x; u.pn = 6; }
            else { const int k = idx - npm, j = k / 7, q = k - j * 7; u.pm = j < 8 ? x * 8 + j : 64 + x; u.pn = q < 6 ? q : 7; }
            return true;
        }
        const int nw = G - n_ssm_wg(G);
        int idx;
        if (i == 0) idx = c; else if (c >= nw) return false; else idx = G + (i - 1) * nw + c;
        if (idx >= 66 * 8) return false;
        if (idx < 66) { u.pm = idx; u.pn = 6; } else { const int k = idx - 66, j = k / 7, q = k - j * 7; u.pm = j; u.pn = q < 6 ? q : 7; }
        return true;
    }
    __device__ __forceinline__ void a_ready(const Unit&) const {}
    __device__ __forceinline__ void done(const Unit& u) const {
        if (u.pn == 6) {
            asm volatile("s_waitcnt vmcnt(0)" ::: "memory");
            if ((threadIdx.x & 63) == 0) (void)__hip_atomic_fetch_add(cnt, 1u, __ATOMIC_RELAXED, __HIP_MEMORY_SCOPE_AGENT);
        }
    }
};

__device__ __forceinline__ unsigned cvt_pk_bf16(float lo, float hi) { unsigned r; asm volatile("v_cvt_pk_bf16_f32 %0, %1, %2" : "=v"(r) : "v"(lo), "v"(hi)); return r; }
typedef float f32x2 __attribute__((ext_vector_type(2)));
__device__ __forceinline__ f32x2 gelu_pk(f32x2 v) {
    const f32x2 av = __builtin_elementwise_abs(v), d = av * 0.2316418882f + 1.0f;
    f32x2 t; t.x = __builtin_amdgcn_rcpf(d.x); t.y = __builtin_amdgcn_rcpf(d.y);
    f32x2 q = t * 0.5307027145f + (-0.7265760135f); q = q * t + 0.7107068705f; q = q * t + (-0.142248368f); q = q * t + 0.127414796f; q = q * t;
    const f32x2 s = (v * v) * (-0.72134752044f);
    f32x2 e; e.x = __builtin_amdgcn_exp2f(s.x); e.y = __builtin_amdgcn_exp2f(s.y);
    const f32x2 m = v * (q * e), r = v - m;
    f32x2 o; o.x = v.x < 0.f ? m.x : r.x; o.y = v.y < 0.f ? m.y : r.y; return o;
}

template <int ACT  > struct EpiBf16 {
    static constexpr bool PERM = true, AFTER_DRAIN = false; static_assert(ACT == 0 || ACT == 1, "EpiBf16: ACT is 0 (none) or 1 (gelu_pk)");
    bf16_t* O; int ldc; const float* bias; int split_cols; size_t split_stride; float scale0;
    __device__ __forceinline__ void operator()(const f32x4 (&acc)[2][2][4][2], const Unit& u, int wr, int wc, int fr, int fq) const {
        const int row0 = u.pm * BM + wr * 64 + fr; int colt = u.pn * BM; bf16_t* base = O;
        float sc = 1.f; if (split_cols) { const int t = colt / split_cols; base += (size_t)t * split_stride; colt -= t * split_cols; if (t == 0) sc = scale0; }
        const int col0 = colt + wc * 32 + 8 * fq, bcol0 = u.pn * BM + wc * 32 + 8 * fq;
        f32x4 bv[2][2];
#pragma unroll
        for (int bj = 0; bj < 2; ++bj)
#pragma unroll
            for (int n = 0; n < 2; ++n) bv[bj][n] = bias ? *(const f32x4*)(bias + bcol0 + bj * HALF + 4 * n) : (f32x4){0.f, 0.f, 0.f, 0.f};
#pragma unroll
        for (int ai = 0; ai < 2; ++ai)
#pragma unroll
            for (int m = 0; m < 4; ++m) { bf16_t* rowp = base + (size_t)(row0 + ai * HALF + m * 16) * ldc + col0;
#pragma unroll
                for (int bj = 0; bj < 2; ++bj) { f32x4 v0 = acc[ai][bj][m][0] + bv[bj][0], v1 = acc[ai][bj][m][1] + bv[bj][1];
                    if (ACT == 1) { f32x2 a = gelu_pk((f32x2){v0[0], v0[1]}), b = gelu_pk((f32x2){v0[2], v0[3]}), c = gelu_pk((f32x2){v1[0], v1[1]}), d = gelu_pk((f32x2){v1[2], v1[3]});
                        v0 = (f32x4){a.x, a.y, b.x, b.y}; v1 = (f32x4){c.x, c.y, d.x, d.y}; }
                    v0 = v0 * sc; v1 = v1 * sc; u32x4 w; w.x = cvt_pk_bf16(v0[0], v0[1]); w.y = cvt_pk_bf16(v0[2], v0[3]); w.z = cvt_pk_bf16(v1[0], v1[1]); w.w = cvt_pk_bf16(v1[2], v1[3]);
                    *(u32x4*)(rowp + bj * HALF) = w; } }
    }
};
template <class Epi, class Sched, bool ALIGN_EPI = false, bool SP2 = false>
__device__ __forceinline__ void gemm_phase(PG8_LAS unsigned char* lds, const Gemm g, const Sched& S, const Epi& E) {
    const int tid = opaque_tid(), wid = __builtin_amdgcn_readfirstlane(tid >> 6), lane = tid & 63, wr = wid >> 2, wc = wid & 3, fr = lane & 15, fq = lane >> 4;
    const int K = g.K, nt = K / BK;
    unsigned voffA[2], voffB[2];
#pragma unroll
    for (int i = 0; i < 2; ++i) { int R, C; stage_rc(tid * 16 + i * 8192, R, C); const int Rb = Epi::PERM ? ((R & ~31) + perm32(R & 31)) : R;
        voffA[i] = (unsigned)(R * K + C) * 2u; voffB[i] = (unsigned)(Rb * K + C) * 2u; }
    const size_t kstep = (size_t)(BK * 2);
    const size_t hstep = (size_t)HALF * K * 2;
    const size_t tstep = 2 * hstep;
    const unsigned ldsw = (unsigned)wid * 1024u;
    const int aoff = lds_byte(wr * 64 + fr, fq * 8), boff = lds_byte(wc * 32 + fr, fq * 8);
#define PG8_SA(b, h) (((b) * 2 + (h)) * HTB)
#define PG8_SB(b, h) ((4 + (b) * 2 + (h)) * HTB)
#define PG8_STAGE(bufoff, gbase, voff) do { _Pragma("unroll") for (int _i = 0; _i < 2; ++_i) \
        __builtin_amdgcn_global_load_lds((const unsigned*)((const char*)(gbase) + (voff)[_i]), (PG8_LAS unsigned*)(lds + (bufoff) + ldsw + _i * 8192), 16, 0, 0); } while (0)
#define PG8_LDA(dst, b, h) do { _Pragma("unroll") for (int m = 0; m < 4; ++m) _Pragma("unroll") for (int k = 0; k < 2; ++k) dst[m][k] = *(const PG8_LAS bf16x8*)(lds + PG8_SA(b, h) + aoff + m * 2048 + k * 1024); } while (0)
#define PG8_LDB(dst, b, h) do { _Pragma("unroll") for (int n = 0; n < 2; ++n) _Pragma("unroll") for (int k = 0; k < 2; ++k) dst[n][k] = *(const PG8_LAS bf16x8*)(lds + PG8_SB(b, h) + boff + n * 2048 + k * 1024); } while (0)
#define PG8_MMA(ai, bj, At, Bt) do { __builtin_amdgcn_s_setprio(1); _Pragma("unroll") for (int m = 0; m < 4; ++m) _Pragma("unroll") for (int n = 0; n < 2; ++n) _Pragma("unroll") for (int k = 0; k < 2; ++k) \
        acc[ai][bj][m][n] = __builtin_amdgcn_mfma_f32_16x16x32_bf16(Bt[n][k], At[m][k], acc[ai][bj][m][n], 0, 0, 0); __builtin_amdgcn_s_setprio(0); } while (0)
#define PG8_WAIT_V(n) asm volatile("s_waitcnt vmcnt(" #n ")" ::: "memory")
#define PG8_WAIT_L(n) asm volatile("s_waitcnt lgkmcnt(" #n ")" ::: "memory")
#define PG8_BAR __builtin_amdgcn_s_barrier()
#define PG8_SCHED __builtin_amdgcn_sched_barrier(0)
    Unit cur, nxt; int ui = 0;
    if (!S.next(0, cur)) return;
    f32x4 acc[2][2][4][2];
#pragma unroll
    for (int a = 0; a < 2; ++a)
#pragma unroll
        for (int b = 0; b < 2; ++b)
#pragma unroll
            for (int m = 0; m < 4; ++m)
#pragma unroll
                for (int n = 0; n < 2; ++n) acc[a][b][m][n] = (f32x4){0.f, 0.f, 0.f, 0.f};
    bf16x8 At[4][2], B0[2][2], B1[2][2];
    const char* cA = (const char*)g.A + (size_t)cur.pm * tstep; const char* cB = (const char*)g.Bt + (size_t)cur.pn * tstep;
    S.a_ready(cur);
    if constexpr (SP2) {
        PG8_STAGE(PG8_SB(0, 0), cB, voffB); PG8_STAGE(PG8_SB(0, 1), cB + hstep, voffB); PG8_STAGE(PG8_SA(0, 0), cA, voffA); PG8_STAGE(PG8_SA(0, 1), cA + hstep, voffA);
        if (wr == 1) PG8_BAR;
        PG8_WAIT_V(2); PG8_BAR;
        PG8_STAGE(PG8_SB(1, 0), cB + kstep, voffB); PG8_STAGE(PG8_SA(1, 0), cA + kstep, voffA); PG8_STAGE(PG8_SB(1, 1), cB + hstep + kstep, voffB);
        PG8_WAIT_V(6); PG8_BAR;
    } else {
        PG8_STAGE(PG8_SB(0, 0), cB, voffB); PG8_STAGE(PG8_SA(0, 0), cA, voffA); PG8_STAGE(PG8_SB(0, 1), cB + hstep, voffB); PG8_STAGE(PG8_SA(0, 1), cA + hstep, voffA);
        if (wr == 1) PG8_BAR;
        PG8_WAIT_V(4); PG8_BAR;
        PG8_STAGE(PG8_SB(1, 0), cB + kstep, voffB); PG8_STAGE(PG8_SA(1, 0), cA + kstep, voffA); PG8_STAGE(PG8_SB(1, 1), cB + hstep + kstep, voffB);
        PG8_WAIT_V(6); PG8_BAR;
    }
    for (;;) {
        const bool has_next = S.next(ui + 1, nxt);
        const char* nA = has_next ? (const char*)g.A + (size_t)nxt.pm * tstep : cA; const char* nB = has_next ? (const char*)g.Bt + (size_t)nxt.pn * tstep : cB;
        for (int t = 0; t < nt; t += 2) {
            const bool last = (t == nt - 2);
            const char* a1 = cA + (size_t)(t + 1) * kstep;
            const char* a2 = last ? nA : cA + (size_t)(t + 2) * kstep; const char* b2 = last ? nB : cB + (size_t)(t + 2) * kstep;
            const char* a3 = a2 + kstep; const char* b3 = b2 + kstep;
            if (last && has_next) S.a_ready(nxt);
            if constexpr (SP2) {
            PG8_LDB(B0, 0, 0); PG8_LDB(B1, 0, 1); PG8_SCHED; PG8_LDA(At, 0, 0); PG8_STAGE(PG8_SA(1, 1), a1 + hstep, voffA);
            PG8_WAIT_V(8); PG8_WAIT_L(0); PG8_BAR; PG8_MMA(0, 0, At, B0); PG8_MMA(0, 1, At, B1); PG8_BAR; PG8_SCHED;
            PG8_LDA(At, 0, 1); PG8_STAGE(PG8_SB(0, 0), b2, voffB); PG8_STAGE(PG8_SB(0, 1), b2 + hstep, voffB); PG8_STAGE(PG8_SA(0, 0), a2, voffA);
            PG8_WAIT_V(8); PG8_WAIT_L(0); PG8_BAR; PG8_MMA(1, 0, At, B0); PG8_MMA(1, 1, At, B1); PG8_BAR; PG8_SCHED;
            PG8_LDB(B0, 1, 0); PG8_LDB(B1, 1, 1); PG8_SCHED; PG8_LDA(At, 1, 0); PG8_STAGE(PG8_SA(0, 1), a2 + hstep, voffA);
            PG8_WAIT_V(8); PG8_WAIT_L(0); PG8_BAR; PG8_MMA(0, 0, At, B0); PG8_MMA(0, 1, At, B1); PG8_BAR; PG8_SCHED;
            PG8_LDA(At, 1, 1); PG8_STAGE(PG8_SB(1, 0), b3, voffB); PG8_STAGE(PG8_SB(1, 1), b3 + hstep, voffB); PG8_STAGE(PG8_SA(1, 0), a3, voffA);
            PG8_WAIT_V(8); PG8_WAIT_L(0); PG8_BAR; PG8_MMA(1, 0, At, B0); PG8_MMA(1, 1, At, B1); PG8_BAR; PG8_SCHED;
            } else {
            PG8_LDB(B0, 0, 0); PG8_SCHED; PG8_LDA(At, 0, 0); PG8_STAGE(PG8_SA(1, 1), a1 + hstep, voffA);
            PG8_WAIT_L(8); PG8_BAR; PG8_WAIT_L(0); PG8_MMA(0, 0, At, B0); PG8_BAR; PG8_SCHED;
            PG8_LDB(B1, 0, 1); PG8_STAGE(PG8_SB(0, 0), b2, voffB);
            PG8_BAR; PG8_WAIT_L(0); PG8_MMA(0, 1, At, B1); PG8_BAR;
            PG8_LDA(At, 0, 1); PG8_STAGE(PG8_SA(0, 0), a2, voffA);
            PG8_BAR; PG8_WAIT_L(0); PG8_MMA(1, 0, At, B0); PG8_BAR; PG8_SCHED;
            PG8_STAGE(PG8_SB(0, 1), b2 + hstep, voffB);
            PG8_WAIT_V(6); PG8_BAR; PG8_MMA(1, 1, At, B1); PG8_BAR;
            PG8_LDB(B0, 1, 0); PG8_SCHED; PG8_LDA(At, 1, 0); PG8_STAGE(PG8_SA(0, 1), a2 + hstep, voffA);
            PG8_WAIT_L(8); PG8_BAR; PG8_WAIT_L(0); PG8_MMA(0, 0, At, B0); PG8_BAR; PG8_SCHED;
            PG8_LDB(B1, 1, 1); PG8_STAGE(PG8_SB(1, 0), b3, voffB);
            PG8_BAR; PG8_WAIT_L(0); PG8_MMA(0, 1, At, B1); PG8_BAR;
            PG8_LDA(At, 1, 1); PG8_STAGE(PG8_SA(1, 0), a3, voffA);
            PG8_BAR; PG8_WAIT_L(0); PG8_MMA(1, 0, At, B0); PG8_BAR; PG8_SCHED;
            PG8_STAGE(PG8_SB(1, 1), b3 + hstep, voffB);
            PG8_WAIT_V(6); PG8_BAR; PG8_MMA(1, 1, At, B1); PG8_BAR;
            }
        }
        if constexpr (ALIGN_EPI) { if (wr == 0) PG8_BAR; }
        if constexpr (!Epi::AFTER_DRAIN) { E(acc, cur, wr, wc, fr, fq); S.done(cur); }
        if (!has_next) break;
#pragma unroll
        for (int a = 0; a < 2; ++a)
#pragma unroll
            for (int b = 0; b < 2; ++b)
#pragma unroll
                for (int m = 0; m < 4; ++m)
#pragma unroll
                    for (int n = 0; n < 2; ++n) acc[a][b][m][n] = (f32x4){0.f, 0.f, 0.f, 0.f};
        cur = nxt; cA = nA; cB = nB; ++ui;
        if constexpr (ALIGN_EPI) { if (wr == 1) PG8_BAR; }
    }
    PG8_WAIT_V(0);
    if constexpr (!ALIGN_EPI) { if (wr == 0) PG8_BAR; }
    PG8_BAR;
    if constexpr (Epi::AFTER_DRAIN) { E.fused(acc, cur, wr, wc, fr, fq, lds, wid, lane); S.done(cur); }
#undef PG8_SA
#undef PG8_SB
#undef PG8_STAGE
#undef PG8_LDA
#undef PG8_LDB
#undef PG8_MMA
#undef PG8_WAIT_V
#undef PG8_WAIT_L
#undef PG8_BAR
#undef PG8_SCHED
}
}

constexpr int LDS_BYTES = 147456;
constexpr int NWAVES = 8;
constexpr float LOG2E = 1.4426950408889634f;
constexpr float QSCALE = 0.125f * LOG2E;
constexpr float U8_SCALE = 64.0f, V8_SCALE = 8.0f;
#define LAS __attribute__((address_space(3)))
typedef unsigned v4u __attribute__((ext_vector_type(4)));
typedef unsigned v2u __attribute__((ext_vector_type(2)));
typedef float f32x4 __attribute__((ext_vector_type(4)));

__device__ __forceinline__ unsigned pkbf(float lo, float hi) { unsigned r; asm("v_cvt_pk_bf16_f32 %0, %1, %2" : "=v"(r) : "v"(lo), "v"(hi)); return r; }
__device__ __forceinline__ float bf2f(unsigned short b) { return __uint_as_float((unsigned)b << 16); }

struct EpiInProj {
    static constexpr bool PERM = false, AFTER_DRAIN = false;
    bf16_t* base; const float* ropet;
    __device__ __forceinline__ void operator()(const pg8::f32x4 (&acc)[2][2][4][2], const pg8::Unit& u, int wr, int wc, int fr, int fq) const {
        const int pn = u.pn;
#pragma unroll
        for (int ai = 0; ai < 2; ++ai)
#pragma unroll
            for (int m = 0; m < 4; ++m) {
                const int row = u.pm * 256 + ai * 128 + wr * 64 + m * 16 + fr;
                if (pn < 4) {
                    bf16_t* dst = base + (size_t)(pn >> 1) * ((size_t)R * 512) + (size_t)row * 512 + (pn & 1) * 256 + wc * 32 + fq * 4;
                    f32x4 cs0 = {1.f, 0.f, 1.f, 0.f}, cs1 = {1.f, 0.f, 1.f, 0.f};
                    if (row < RL) {
                        const int t = row & (SEQ - 1);
                        const float* tp = ropet + ((size_t)(t * 2 + (wc & 1)) * 16 + fq * 4) * 2;
                        cs0 = *(const f32x4*)tp; cs1 = *(const f32x4*)(tp + 4);
                    }
                    const float sc = pn < 2 ? QSCALE : 1.0f;
#pragma unroll
                    for (int bj = 0; bj < 2; ++bj) {
                        const pg8::f32x4 x1 = acc[ai][bj][m][0], x2 = acc[ai][bj][m][1];
                        float o1[4], o2[4];
                        const float c[4] = {cs0[0], cs0[2], cs1[0], cs1[2]}, s[4] = {cs0[1], cs0[3], cs1[1], cs1[3]};
#pragma unroll
                        for (int j = 0; j < 4; ++j) { o1[j] = (x1[j] * c[j] - x2[j] * s[j]) * sc; o2[j] = (x2[j] * c[j] + x1[j] * s[j]) * sc; }
                        v2u w1, w2; w1.x = pkbf(o1[0], o1[1]); w1.y = pkbf(o1[2], o1[3]); w2.x = pkbf(o2[0], o2[1]); w2.y = pkbf(o2[2], o2[3]);
                        *(v2u*)(dst + bj * 128) = w1; *(v2u*)(dst + bj * 128 + 16) = w2;
                    }
                } else {
                    if (pn == 6) {
#pragma unroll
                        for (int bj = 0; bj < 2; ++bj)
#pragma unroll
                            for (int n = 0; n < 2; ++n) { const pg8::f32x4 x = acc[ai][bj][m][n]; v2u w; w.x = pkbf(x[0], x[1]); w.y = pkbf(x[2], x[3]);
                                __hip_atomic_store((unsigned long long*)(base + (size_t)3 * R * 512 + ((size_t)(bj * 8 + wc * 2 + n) * R + row) * 16 + fq * 4), ((unsigned long long)w.y << 32) | w.x, __ATOMIC_RELAXED, __HIP_MEMORY_SCOPE_AGENT); }
                    } else {
                    const int ld = pn < 6 ? 512 : 256, c0 = pn == 5 ? 256 : 0;
                    const size_t boff = pn < 6 ? (size_t)2 * R * 512 : (size_t)3 * R * 512 + (size_t)R * 256;
                    bf16_t* dst = base + boff + (size_t)row * ld + c0 + wc * 32 + fq * 4;
#pragma unroll
                    for (int bj = 0; bj < 2; ++bj)
#pragma unroll
                        for (int n = 0; n < 2; ++n) { const pg8::f32x4 x = acc[ai][bj][m][n]; v2u w; w.x = pkbf(x[0], x[1]); w.y = pkbf(x[2], x[3]); *(v2u*)(dst + bj * 128 + n * 16) = w; }
                    }
                }
            }
    }
};

struct EpiResid {
    static constexpr bool PERM = true, AFTER_DRAIN = false;
    float* xb; const float* modl; const float* xin; const float* cin;
    __device__ __forceinline__ void operator()(const pg8::f32x4 (&acc)[2][2][4][2], const pg8::Unit& u, int wr, int wc, int fr, int fq) const {
#pragma unroll
        for (int ai = 0; ai < 2; ++ai)
#pragma unroll
            for (int m = 0; m < 4; ++m) {
                const int row = u.pm * 256 + ai * 128 + wr * 64 + m * 16 + fr, col0 = u.pn * 256 + wc * 32 + fq * 8;
                const float* mm = modl + (size_t)modset(row) * (NMOD * D) + 2 * D + col0;
                float* xr = xb + (size_t)row * D + col0;
                const float* xs = (row < RL ? xin + (size_t)row * D : cin + (size_t)(row - RL) * D) + col0;
#pragma unroll
                for (int bj = 0; bj < 2; ++bj)
#pragma unroll
                    for (int n = 0; n < 2; ++n) {
                        const pg8::f32x4 g = *(const pg8::f32x4*)(mm + bj * 128 + n * 4);
                        pg8::f32x4 xv = *(const pg8::f32x4*)(xs + bj * 128 + n * 4);
                        xv = xv + g * acc[ai][bj][m][n];
                        *(pg8::f32x4*)(xr + bj * 128 + n * 4) = xv;
                    }
            }
    }
};

__device__ __forceinline__ void transpose_item(const float* W, int K, int N, bf16_t* WT, LAS float* scr, int item, int lane) {
    const int nblk = N / 32, kb = item / nblk, nb = item % nblk, k0 = 64 * kb, n0 = 32 * nb;
#pragma unroll 8
    for (int i = 0; i < 32; ++i) { const int kk = 2 * i + (lane >> 5); scr[kk * 33 + (lane & 31)] = W[(size_t)(k0 + kk) * N + n0 + (lane & 31)]; }
    asm volatile("s_waitcnt lgkmcnt(0)" ::: "memory");
    const int c = lane & 7;
#pragma unroll
    for (int j = 0; j < 4; ++j) { const int n = (lane >> 3) + 8 * j; const LAS float* s = scr + (8 * c) * 33 + n;
        v4u o; o.x = pkbf(s[0 * 33], s[1 * 33]); o.y = pkbf(s[2 * 33], s[3 * 33]); o.z = pkbf(s[4 * 33], s[5 * 33]); o.w = pkbf(s[6 * 33], s[7 * 33]);
        *(v4u*)(WT + (size_t)(n0 + n) * K + k0 + 8 * c) = o; }
    asm volatile("s_waitcnt lgkmcnt(0)" ::: "memory");
}

__device__ __forceinline__ void normmod_row_bf16(const float* xrow, const float* g, const float* shift, const float* scale, bf16_t* orow, int lane) {
    f32x4 v[4]; float ss = 0.f;
#pragma unroll
    for (int j = 0; j < 4; ++j) { v[j] = ((const f32x4*)xrow)[lane + 64 * j]; ss += (v[j][0] * v[j][0] + v[j][1] * v[j][1]) + (v[j][2] * v[j][2] + v[j][3] * v[j][3]); }
    ss = wave_sum(ss);
    const float r = rsqrtf(ss * (1.0f / D) + EPS);
#pragma unroll
    for (int j = 0; j < 4; ++j) {
        const f32x4 gg = ((const f32x4*)g)[lane + 64 * j], sh = ((const f32x4*)shift)[lane + 64 * j], sc = ((const f32x4*)scale)[lane + 64 * j];
        float o[4];
#pragma unroll
        for (int e = 0; e < 4; ++e) o[e] = v[j][e] * r * gg[e] * (1.0f + sc[e]) + sh[e];
        v2u w; w.x = pkbf(o[0], o[1]); w.y = pkbf(o[2], o[3]);
        ((v2u*)orow)[lane + 64 * j] = w;
    }
}

template <class SrcF>
__device__ __forceinline__ void normmod_rows(const SrcF& src, const float* g, const float* modl, int shift_vec, int scale_vec, bf16_t* hb, int MR, int gw, int NGW, int lane) {
    if (gw >= MR) return;
    f32x4 ca[4], cb[4], vn[4];
    int cur = -1;
    {
        const float* x0 = src(gw);
#pragma unroll
        for (int j = 0; j < 4; ++j) vn[j] = ((const f32x4*)x0)[lane + 64 * j];
    }
    for (int row = gw; row < MR; row += NGW) {
        f32x4 v[4];
#pragma unroll
        for (int j = 0; j < 4; ++j) v[j] = vn[j];
        if (row + NGW < MR) {
            const float* xn = src(row + NGW);
#pragma unroll
            for (int j = 0; j < 4; ++j) vn[j] = ((const f32x4*)xn)[lane + 64 * j];
        }
        const int ms = modset(row);
        if (ms != cur) {
            cur = ms;
            const float* m = modl + (size_t)ms * (NMOD * D);
#pragma unroll
            for (int j = 0; j < 4; ++j) {
                const f32x4 gg = ((const f32x4*)g)[lane + 64 * j], sh = ((const f32x4*)(m + shift_vec * D))[lane + 64 * j], sc = ((const f32x4*)(m + scale_vec * D))[lane + 64 * j];
#pragma unroll
                for (int e = 0; e < 4; ++e) { ca[j][e] = gg[e] * (1.0f + sc[e]); cb[j][e] = sh[e]; }
            }
        }
        float ss = 0.f;
#pragma unroll
        for (int j = 0; j < 4; ++j) ss += (v[j][0] * v[j][0] + v[j][1] * v[j][1]) + (v[j][2] * v[j][2] + v[j][3] * v[j][3]);
        ss = wave_sum(ss);
        const float r = rsqrtf(ss * (1.0f / D) + EPS);
        bf16_t* orow = hb + (size_t)row * D;
#pragma unroll
        for (int j = 0; j < 4; ++j) {
            v2u w; w.x = pkbf(v[j][0] * r * ca[j][0] + cb[j][0], v[j][1] * r * ca[j][1] + cb[j][1]); w.y = pkbf(v[j][2] * r * ca[j][2] + cb[j][2], v[j][3] * r * ca[j][3] + cb[j][3]);
            ((v2u*)orow)[lane + 64 * j] = w;
        }
    }
}

typedef short bf16x8 __attribute__((ext_vector_type(8)));
typedef short s16x4 __attribute__((ext_vector_type(4)));
typedef float f32x16 __attribute__((ext_vector_type(16)));
constexpr int AT_STAGE = 32768;
constexpr int AT_QB = 128;

__device__ __forceinline__ float swap32(float v) {
    auto rr = __builtin_amdgcn_permlane32_swap(__float_as_uint(v), __float_as_uint(v), false, false);
    return (threadIdx.x & 32) ? __uint_as_float(rr[0]) : __uint_as_float(rr[1]);
}
__device__ __forceinline__ s16x4 vtr(const LAS unsigned char* p) {
    typedef short v4i16_t __attribute__((ext_vector_type(4)));
    return __builtin_bit_cast(s16x4, __builtin_amdgcn_ds_read_tr16_b64_v4i16((LAS v4i16_t*)p));
}

struct AttnUnit { int qrow0, hs0, kb0, n0, kb1, n1; };

__device__ __forceinline__ void attn_dma_k(const P& p, LAS unsigned char* slot, int krow0, int h4, int wave, int lane) {
    const int key = wave * 8 + (lane >> 3), c = (lane & 7) ^ (key & 7);
#pragma unroll
    for (int s = 0; s < 2; ++s) {
        const bf16_t* src = p.kb() + (size_t)(krow0 + key) * 512 + (h4 * 2 + s) * 64 + c * 8;
        __builtin_amdgcn_global_load_lds((const unsigned*)src, (LAS unsigned*)(slot + s * 8192 + wave * 1024), 16, 0, 0);
    }
}
__device__ __forceinline__ void attn_dma_v(const P& p, LAS unsigned char* slot, int krow0, int h4, int wave, int lane) {
#pragma unroll
    for (int q = 0; q < 2; ++q) {
        const int pi = wave * 2 + q, db = pi >> 2, j = pi & 3;
        const bf16_t* src = p.vb() + (size_t)(krow0 + 16 * j + (lane >> 2)) * 512 + h4 * 128 + 32 * db + 8 * (lane & 3);
        __builtin_amdgcn_global_load_lds((const unsigned*)src, (LAS unsigned*)(slot + pi * 1024), 16, 0, 0);
    }
}
constexpr int AT_KSLOT = 16384, AT_VOFF = 3 * 16384;

__device__ __forceinline__ void attn_qk(f32x16& s0, f32x16& s1, const LAS unsigned char* kread, const bf16x8 (&qr)[4], int ksw, int h) {
#pragma unroll
    for (int i = 0; i < 16; ++i) { s0[i] = 0.f; s1[i] = 0.f; }
#pragma unroll
    for (int d0 = 0; d0 < 4; ++d0) {
        const int co = ((2 * d0 + h) ^ ksw) * 16;
        const bf16x8 k0 = *(const LAS bf16x8*)(kread + co);
        const bf16x8 k1 = *(const LAS bf16x8*)(kread + 4096 + co);
        s0 = __builtin_amdgcn_mfma_f32_32x32x16_bf16(k0, qr[d0], s0, 0, 0, 0);
        s1 = __builtin_amdgcn_mfma_f32_32x32x16_bf16(k1, qr[d0], s1, 0, 0, 0);
    }
}

__device__ __forceinline__ void attn_unit(const P& p, int l, const AttnUnit& u, LAS unsigned char* lds, float lam, float lam_init) {
    const int tid = opaque_tid(), lane = tid & 63, r = lane & 31, h = lane >> 5;
    const int wave = __builtin_amdgcn_readfirstlane(tid >> 6), s = wave >> 2, w4 = wave & 3;
    const int h4 = u.hs0, NT = u.n0 + u.n1;
    const int qrow = u.qrow0 + w4 * 32 + r;
#define AT_KROW(t) ((t) < u.n0 ? u.kb0 + (t) * 64 : u.kb1 + ((t) - u.n0) * 64)
    attn_dma_k(p, lds, AT_KROW(0), h4, wave, lane);
    attn_dma_v(p, lds + AT_VOFF, AT_KROW(0), h4, wave, lane);
    if (NT > 1) attn_dma_k(p, lds + AT_KSLOT, AT_KROW(1), h4, wave, lane);
    bf16x8 qr[4];
    {
        const bf16_t* qp = p.qb() + (size_t)qrow * 512 + (h4 * 2 + s) * 64 + h * 8;
#pragma unroll
        for (int d0 = 0; d0 < 4; ++d0) qr[d0] = *(const bf16x8*)(qp + d0 * 16);
    }
    f32x16 o[4];
#pragma unroll
    for (int dt = 0; dt < 4; ++dt)
#pragma unroll
        for (int i = 0; i < 16; ++i) o[dt][i] = 0.f;
    float m = -1e30f, lsum = 0.f;
    const LAS unsigned char* kread = lds + s * 8192 + r * 128;
    const int ksw = r & 7;
    const LAS unsigned char* vread = lds + AT_VOFF + (4 * h + ((lane & 15) >> 2)) * 64 + ((lane >> 4) & 1) * 32 + (lane & 3) * 8;
    asm volatile("s_waitcnt vmcnt(0)" ::: "memory");
    __builtin_amdgcn_s_barrier();
    f32x16 s0, s1;
    attn_qk(s0, s1, kread, qr, ksw, h);
    int kslot_n = AT_KSLOT, kslot_nn = 2 * AT_KSLOT;
    for (int t = 0; t < NT; ++t) {
        if (t + 2 < NT) attn_dma_k(p, lds + kslot_nn, AT_KROW(t + 2), h4, wave, lane);
        if (t + 1 < NT) attn_dma_v(p, lds + AT_VOFF + ((t + 1) & 1) * 16384, AT_KROW(t + 1), h4, wave, lane);
        f32x16 n0, n1;
        if (t + 1 < NT) attn_qk(n0, n1, kread + kslot_n, qr, ksw, h);
        float mx = fmaxf(s0[0], s1[0]);
#pragma unroll
        for (int i = 1; i < 16; ++i) mx = fmaxf(mx, fmaxf(s0[i], s1[i]));
        mx = fmaxf(mx, swap32(mx));
        const float mnew = fmaxf(m, mx);
        if (__any(mnew > m + 8.0f)) {
            const float alpha = __builtin_amdgcn_exp2f(m - mnew);
            lsum *= alpha;
#pragma unroll
            for (int dt = 0; dt < 4; ++dt)
#pragma unroll
                for (int i = 0; i < 16; ++i) o[dt][i] *= alpha;
            m = mnew;
        }
        {
            typedef float f2_t __attribute__((ext_vector_type(2)));
            const f2_t m2 = (f2_t){m, m};
            f2_t ps2 = (f2_t){0.f, 0.f};
#pragma unroll
            for (int i = 0; i < 16; i += 2) {
                f2_t a = (f2_t){s0[i], s0[i + 1]} - m2, b = (f2_t){s1[i], s1[i + 1]} - m2;
                a = (f2_t){__builtin_amdgcn_exp2f(a.x), __builtin_amdgcn_exp2f(a.y)}; b = (f2_t){__builtin_amdgcn_exp2f(b.x), __builtin_amdgcn_exp2f(b.y)};
                s0[i] = a.x; s0[i + 1] = a.y; s1[i] = b.x; s1[i + 1] = b.y;
                ps2 += a; ps2 += b;
            }
            lsum += ps2.x + ps2.y;
        }
        bf16x8 pw[4];
#pragma unroll
        for (int ks = 0; ks < 4; ++ks) {
            v4u w;
            if (ks < 2) { w.x = pkbf(s0[8 * ks + 0], s0[8 * ks + 1]); w.y = pkbf(s0[8 * ks + 2], s0[8 * ks + 3]); w.z = pkbf(s0[8 * ks + 4], s0[8 * ks + 5]); w.w = pkbf(s0[8 * ks + 6], s0[8 * ks + 7]); }
            else { const int b = 8 * (ks - 2); w.x = pkbf(s1[b + 0], s1[b + 1]); w.y = pkbf(s1[b + 2], s1[b + 3]); w.z = pkbf(s1[b + 4], s1[b + 5]); w.w = pkbf(s1[b + 6], s1[b + 7]); }
            pw[ks] = __builtin_bit_cast(bf16x8, w);
        }
        {
            const int va = (int)(unsigned)(size_t)vread + (t & 1) * 16384;
            s16x4 la[4], ha[4], lb[4], hb_[4];
#define AT_TR(dst, off) asm volatile("ds_read_b64_tr_b16 %0, %1 offset:%c2" : "=&v"(dst) : "v"(va), "i"(off) : "memory")
#define AT_VG(L, H, KS) do { _Pragma("unroll") for (int dt = 0; dt < 4; ++dt) { AT_TR(L[dt], dt * 4096 + (KS) * 1024); AT_TR(H[dt], dt * 4096 + (KS) * 1024 + 512); } } while (0)
#define AT_WAIT(N, L, H) asm volatile("s_waitcnt lgkmcnt(" #N ")" : "+v"(L[0]), "+v"(L[1]), "+v"(L[2]), "+v"(L[3]), "+v"(H[0]), "+v"(H[1]), "+v"(H[2]), "+v"(H[3]) :: "memory")
#define AT_PVG(L, H, KS) do { _Pragma("unroll") for (int dt = 0; dt < 4; ++dt) { const bf16x8 vf_ = (bf16x8){L[dt][0], L[dt][1], L[dt][2], L[dt][3], H[dt][0], H[dt][1], H[dt][2], H[dt][3]}; \
            o[dt] = __builtin_amdgcn_mfma_f32_32x32x16_bf16(vf_, pw[KS], o[dt], 0, 0, 0); } } while (0)
            AT_VG(la, ha, 0); AT_VG(lb, hb_, 1);
            AT_WAIT(8, la, ha); AT_PVG(la, ha, 0);
            AT_VG(la, ha, 2);
            AT_WAIT(8, lb, hb_); AT_PVG(lb, hb_, 1);
            AT_VG(lb, hb_, 3);
            AT_WAIT(8, la, ha); AT_PVG(la, ha, 2);
            AT_WAIT(0, lb, hb_); AT_PVG(lb, hb_, 3);
#undef AT_TR
#undef AT_VG
#undef AT_WAIT
#undef AT_PVG
        }
        s0 = n0; s1 = n1;
        kslot_n = kslot_nn; kslot_nn = (kslot_n + AT_KSLOT) % (3 * AT_KSLOT);
        asm volatile("s_waitcnt vmcnt(0)" ::: "memory");
        __builtin_amdgcn_s_barrier();
    }
#undef AT_KROW
    const float inv = 1.0f / (lsum + swap32(lsum));
    __syncthreads();
    LAS float* xch = (LAS float*)lds + w4 * 4096;
    if (s == 1) {
#pragma unroll
        for (int dt = 0; dt < 4; ++dt)
#pragma unroll
            for (int i = 0; i < 16; ++i) xch[(dt * 16 + i) * 64 + lane] = o[dt][i] * inv;
    }
    __syncthreads();
    if (s == 0) {
        float ss = 0.f;
#pragma unroll
        for (int dt = 0; dt < 4; ++dt)
#pragma unroll
            for (int i = 0; i < 16; ++i) { const float v = o[dt][i] * inv - lam * xch[(dt * 16 + i) * 64 + lane]; o[dt][i] = v; ss += v * v; }
        ss += swap32(ss);
        const float rn = rsqrtf(ss * (1.0f / VD) + EPS) * (1.0f - lam_init);
        bf16_t* dst = p.mixb() + (size_t)qrow * D + h4 * VD + 4 * h;
        const float* gp = p.sp_subln() + l * VD + 4 * h;
#pragma unroll
        for (int dt = 0; dt < 4; ++dt)
#pragma unroll
            for (int i4 = 0; i4 < 4; ++i4) {
                const f32x4 g = *(const f32x4*)(gp + 32 * dt + 8 * i4);
                v2u w; w.x = pkbf(o[dt][4 * i4 + 0] * rn * g[0], o[dt][4 * i4 + 1] * rn * g[1]); w.y = pkbf(o[dt][4 * i4 + 2] * rn * g[2], o[dt][4 * i4 + 3] * rn * g[3]);
                *(v2u*)(dst + 32 * dt + 8 * i4) = w;
            }
    }
    __syncthreads();
}

__device__ __forceinline__ void attn_phase(const P& p, int l, LAS unsigned char* lds, bool with_ctx) {
    const int lane = threadIdx.x & 63;
    const float lam = p.sp_lam()[l * 2], lam_init = p.sp_lam()[l * 2 + 1];
    const int bx = blockIdx.x, G = gridDim.x;
    for (int i = bx; i < 512; i += G) {
        const int combo = i & 7, qblk = i >> 3, b = combo >> 2, h4 = combo & 3;
        AttnUnit u{b * SEQ + qblk * AT_QB, h4, b * SEQ, SEQ / 64, RL + b * CTX, CTX / 64};
        attn_unit(p, l, u, lds, lam, lam_init);
    }
    if (with_ctx) {
        for (int i = bx; i < 16; i += G) {
            const int combo = i & 7, qblk = i >> 3, b = combo >> 2, h4 = combo & 3;
            AttnUnit u{RL + b * CTX + qblk * AT_QB, h4, RL + b * CTX, CTX / 64, 0, 0};
            attn_unit(p, l, u, lds, lam, lam_init);
        }
    }
}

typedef float f32x4v __attribute__((ext_vector_type(4)));
constexpr int NPOS = 132, NPOSP = 144;
constexpr int ES_LD = 132, HB_LD = 136;
constexpr int U_LD = 264;

__device__ __forceinline__ int ssm_rowbase(int b, int dr, int n) {
    if (dr == 0) return n < 4 ? RL + b * CTX + 64 * n : b * SEQ + 64 * (n - 4);
    return n < 4 ? RL + b * CTX + 64 * (3 - n) : b * SEQ + 64 * (131 - n);
}
__device__ __forceinline__ void ssm_zoh(const P& p, int cb, int pp, float& lre, float& lim, float& step, float& cr, float& ci) {
    lre = p.lre()[cb * PS + pp]; lim = p.lim()[cb * PS + pp]; step = expf(p.lstep()[cb]);
    const float er = expf(lre * step), ar = er * cosf(lim * step), ai = er * sinf(lim * step);
    const float nr = ar - 1.0f, den = lre * lre + lim * lim;
    cr = (nr * lre + ai * lim) / den; ci = (ai * lre - nr * lim) / den;
}
__device__ __forceinline__ void ssm_apow(float lre, float lim, float step, float e, float& pr, float& pi) {
    const float mag = expf(lre * step * e), ang = lim * step * e;
    pr = mag * cosf(ang); pi = mag * sinf(ang);
}

__device__ __forceinline__ void ssm_tables(const P& p, LAS unsigned char* lds) {
    const int tid = opaque_tid(), lane = tid & 63, wave = __builtin_amdgcn_readfirstlane(tid >> 6);
    const int G = gridDim.x, gw = blockIdx.x * NWAVES + wave, NGW = G * NWAVES;
    for (int it = gw; it < 64 * 64 * 2; it += NGW) {
        const int which = it >= 64 * 64, r = it & (64 * 64 - 1), cb = r >> 6, x = r & 63, dr = (cb >> 4) & 1;
        float lre, lim, step, cr, ci; ssm_zoh(p, cb, lane, lre, lim, step, cr, ci);
        if (!which) {
            float pr, pi; ssm_apow(lre, lim, step, (float)(dr ? x : 63 - x), pr, pi);
            unsigned wr[8], wi[8];
#pragma unroll
            for (int hh = 0; hh < 16; hh += 2) {
                float zr[2], zi[2];
#pragma unroll
                for (int q = 0; q < 2; ++q) {
                    const float br = p.bre()[((size_t)cb * PS + lane) * SG + hh + q], bi = p.bim()[((size_t)cb * PS + lane) * SG + hh + q];
                    const float bbr = cr * br - ci * bi, bbi = cr * bi + ci * br;
                    zr[q] = pr * bbr - pi * bbi; zi[q] = pr * bbi + pi * bbr;
                }
                wr[hh >> 1] = pkbf(zr[0], zr[1]); wi[hh >> 1] = pkbf(zi[0], zi[1]);
            }
            const int ks_ = x >> 1, fqb = (x & 1) * 2;
            bf16_t* d0 = p.ssm_we() + ((((size_t)cb * 8 + (lane >> 4)) * 32 + ks_) * 64 + fqb * 16 + (lane & 15)) * 8;
            bf16_t* d1 = p.ssm_we() + ((((size_t)cb * 8 + 4 + (lane >> 4)) * 32 + ks_) * 64 + fqb * 16 + (lane & 15)) * 8;
            *(v4u*)d0 = (v4u){wr[0], wr[1], wr[2], wr[3]}; *(v4u*)(d0 + 128) = (v4u){wr[4], wr[5], wr[6], wr[7]};
            *(v4u*)d1 = (v4u){wi[0], wi[1], wi[2], wi[3]}; *(v4u*)(d1 + 128) = (v4u){wi[4], wi[5], wi[6], wi[7]};
        } else {
            float pr, pi; ssm_apow(lre, lim, step, (float)(dr ? 64 - x : x + 1), pr, pi);
            for (int hh = 0; hh < 16; ++hh) {
                const float c_r = p.cre()[((size_t)cb * SG + hh) * PS + lane], c_i = p.cim()[((size_t)cb * SG + hh) * PS + lane];
                bf16_t* d = p.ssm_wc() + ((size_t)cb * 1024 + x * 16 + hh) * 128;
                d[lane] = (bf16_t)(pkbf(c_r * pr - c_i * pi, 0.f) & 0xffff);
                d[64 + lane] = (bf16_t)(pkbf(-c_r * pi - c_i * pr, 0.f) & 0xffff);
            }
        }
    }
    LAS float* zs = (LAS float*)lds + wave * (2 * 64 * 16);
    for (int it = gw; it < 64 * 64; it += NGW) {
        const int cb = it >> 6, j = it & 63;
        float lre, lim, step, cr, ci; ssm_zoh(p, cb, lane, lre, lim, step, cr, ci);
        float pr, pi; ssm_apow(lre, lim, step, (float)j, pr, pi);
#pragma unroll
        for (int hh = 0; hh < 16; ++hh) {
            const float br = p.bre()[((size_t)cb * PS + lane) * SG + hh], bi = p.bim()[((size_t)cb * PS + lane) * SG + hh];
            const float bbr = cr * br - ci * bi, bbi = cr * bi + ci * br;
            zs[lane * 16 + hh] = pr * bbr - pi * bbi; zs[1024 + lane * 16 + hh] = pr * bbi + pi * bbr;
        }
        asm volatile("s_waitcnt lgkmcnt(0)" ::: "memory");
        const int h = lane >> 2, h0 = (lane & 3) * 4;
        float acc[4] = {0.f, 0.f, 0.f, 0.f};
        for (int pp = 0; pp < PS; ++pp) {
            const float c_r = p.cre()[((size_t)cb * SG + h) * PS + pp], c_i = p.cim()[((size_t)cb * SG + h) * PS + pp];
            const f32x4v zr = *(const LAS f32x4v*)(zs + pp * 16 + h0), zi = *(const LAS f32x4v*)(zs + 1024 + pp * 16 + h0);
#pragma unroll
            for (int e = 0; e < 4; ++e) acc[e] += c_r * zr[e] - c_i * zi[e];
        }
        v2u w; w.x = pkbf(acc[0], acc[1]); w.y = pkbf(acc[2], acc[3]);
        *(v2u*)(p.ssm_km() + (((size_t)cb * 64 + j) * 16 + h) * 16 + h0) = w;
        asm volatile("s_waitcnt lgkmcnt(0)" ::: "memory");
    }
}

__device__ __forceinline__ void ssm_a_item(const P& p, int l, int b, int dr, int g, LAS unsigned char* lds) {
    const int tid = opaque_tid(), lane = tid & 63, fr = lane & 15, fq = lane >> 4;
    const int wave = __builtin_amdgcn_readfirstlane(tid >> 6);
    const int cb = (l * 2 + dr) * 16 + g;
    LAS float* Es = (LAS float*)lds;
    LAS bf16_t* Hb = (LAS bf16_t*)(lds + NPOSP * ES_LD * 4);
    {
        pg8::f32x4 acc[9];
#pragma unroll
        for (int nt = 0; nt < 9; ++nt) acc[nt] = (pg8::f32x4){0.f, 0.f, 0.f, 0.f};
        const bf16_t* We = p.ssm_we() + (((size_t)cb * 8 + wave) * 32 * 64 + lane) * 8;
        constexpr int BS_LD = 144;
        LAS unsigned char* Bs = lds + NPOSP * ES_LD * 4;
        const bf16_t* sp[3];
#pragma unroll
        for (int i = 0; i < 3; ++i) { const int pid = tid + i * (NWAVES * 64); int pos = pid >> 3; pos = pos < NPOS ? pos : NPOS - 1; sp[i] = p.ub() + ((size_t)g * R + ssm_rowbase(b, dr, pos)) * 16 + (pid & 7) * 8; }
        v4u st[3], sn[3];
#pragma unroll
        for (int i = 0; i < 3; ++i) if (tid + i * (NWAVES * 64) < NPOSP * 8) { st[i] = *(const v4u*)sp[i]; sn[i] = *(const v4u*)(sp[i] + 64); }
#pragma unroll
        for (int i = 0; i < 3; ++i) { const int pid = tid + i * (NWAVES * 64); if (pid < NPOSP * 8) *(LAS v4u*)(Bs + (pid >> 3) * BS_LD + (pid & 7) * 16) = st[i]; }
        bf16x8 a0 = *(const bf16x8*)(We), a1 = *(const bf16x8*)(We + 512), n0 = *(const bf16x8*)(We + 2 * 512), n1 = *(const bf16x8*)(We + 3 * 512);
        __syncthreads();
#pragma unroll 1
        for (int c = 0; c < 16; ++c) {
            const bool more = c + 1 < 16, more2 = c + 2 < 16;
#pragma unroll
            for (int i = 0; i < 3; ++i) st[i] = sn[i];
            bf16x8 m0 = n0, m1 = n1;
            if (more2) {
#pragma unroll
                for (int i = 0; i < 3; ++i) if (tid + i * (NWAVES * 64) < NPOSP * 8) sn[i] = *(const v4u*)(sp[i] + (size_t)(c + 2) * 64);
                m0 = *(const bf16x8*)(We + (2 * c + 4) * 512); m1 = *(const bf16x8*)(We + (2 * c + 5) * 512);
            }
            const LAS unsigned char* bb = Bs + (c & 1) * (NPOSP * BS_LD) + fr * BS_LD + fq * 16;
#pragma unroll
            for (int nt = 0; nt < 9; ++nt) {
                const bf16x8 b0 = *(const LAS bf16x8*)(bb + nt * 16 * BS_LD), b1 = *(const LAS bf16x8*)(bb + nt * 16 * BS_LD + 64);
                acc[nt] = __builtin_amdgcn_mfma_f32_16x16x32_bf16(a0, b0, acc[nt], 0, 0, 0);
                acc[nt] = __builtin_amdgcn_mfma_f32_16x16x32_bf16(a1, b1, acc[nt], 0, 0, 0);
            }
            if (more) {
#pragma unroll
                for (int i = 0; i < 3; ++i) { const int pid = tid + i * (NWAVES * 64); if (pid < NPOSP * 8) *(LAS v4u*)(Bs + ((c + 1) & 1) * (NPOSP * BS_LD) + (pid >> 3) * BS_LD + (pid & 7) * 16) = st[i]; }
            }
            a0 = n0; a1 = n1; n0 = m0; n1 = m1;
            __syncthreads();
        }
#pragma unroll
        for (int nt = 0; nt < 9; ++nt) *(LAS pg8::f32x4*)(Es + (16 * nt + fr) * ES_LD + wave * 16 + 4 * fq) = acc[nt];
    }
    __syncthreads();
    if (wave == 0) {
        const float a64r = p.sp_a64()[(cb * PS + lane) * 2], a64i = p.sp_a64()[(cb * PS + lane) * 2 + 1];
        float hr = 0.f, hi = 0.f;
        for (int k0 = 0; k0 < NPOS; k0 += 4) {
            float er[4], ei[4];
#pragma unroll
            for (int q = 0; q < 4; ++q) { er[q] = Es[(k0 + q) * ES_LD + lane]; ei[q] = Es[(k0 + q) * ES_LD + 64 + lane]; }
#pragma unroll
            for (int q = 0; q < 4; ++q) {
                const int k = k0 + q;
                Hb[k * HB_LD + lane] = (bf16_t)(pkbf(hr, 0.f) & 0xffff); Hb[k * HB_LD + 64 + lane] = (bf16_t)(pkbf(hi, 0.f) & 0xffff);
                const float nr = a64r * hr - a64i * hi + er[q], ni = a64r * hi + a64i * hr + ei[q];
                hr = nr; hi = ni;
            }
        }
        for (int k = NPOS; k < NPOSP; ++k) { Hb[k * HB_LD + lane] = 0; Hb[k * HB_LD + 64 + lane] = 0; }
    }
    __syncthreads();
    {
        const bf16_t* Wc = p.ssm_wc() + ((size_t)cb * 1024 + fr) * 128 + fq * 8;
        bf16x8 an[4], am[4];
#pragma unroll
        for (int ks = 0; ks < 4; ++ks) { an[ks] = *(const bf16x8*)(Wc + (size_t)(wave * 8) * 16 * 128 + ks * 32); am[ks] = *(const bf16x8*)(Wc + (size_t)(wave * 8 + 1) * 16 * 128 + ks * 32); }
#pragma unroll 1
        for (int tt = 0; tt < 8; ++tt) {
            const int t = wave * 8 + tt;
            bf16x8 a[4];
#pragma unroll
            for (int ks = 0; ks < 4; ++ks) { a[ks] = an[ks]; an[ks] = am[ks]; }
            if (tt + 2 < 8) {
#pragma unroll
                for (int ks = 0; ks < 4; ++ks) am[ks] = *(const bf16x8*)(Wc + (size_t)(t + 2) * 16 * 128 + ks * 32);
            }
#pragma unroll
            for (int nt = 0; nt < 9; ++nt) {
                pg8::f32x4 acc = (pg8::f32x4){0.f, 0.f, 0.f, 0.f};
#pragma unroll
                for (int ks = 0; ks < 4; ++ks) {
                    const bf16x8 bv = *(const LAS bf16x8*)(Hb + (16 * nt + fr) * HB_LD + ks * 32 + fq * 8);
                    acc = __builtin_amdgcn_mfma_f32_16x16x32_bf16(a[ks], bv, acc, 0, 0, 0);
                }
                const int n = 16 * nt + fr;
                if (n < NPOS) *(pg8::f32x4*)(p.yc() + ((size_t)dr * R + ssm_rowbase(b, dr, n) + t) * 256 + g * 16 + 4 * fq) = acc;
            }
        }
    }
    __syncthreads();
}

__device__ __forceinline__ void ssm_b_unit(const P& p, int l, int row0, int seq0, int nseq, LAS unsigned char* lds) {
    const int tid = opaque_tid(), lane = tid & 63, fr = lane & 15, fq = lane >> 4;
    const int wave = __builtin_amdgcn_readfirstlane(tid >> 6);
    LAS bf16_t* U = (LAS bf16_t*)lds;
    LAS bf16_t* YG = U + 64 * U_LD;
    LAS bf16_t* PW = YG + 64 * U_LD;
    LAS bf16_t* DF = PW + 80 * U_LD;
    for (int i = tid; i < 64 * 32; i += NWAVES * 64) { const int rr = i >> 5, c8 = i & 31; *(LAS v4u*)(U + rr * U_LD + c8 * 8) = *(const v4u*)(p.ub() + ((size_t)(c8 >> 1) * R + row0 + rr) * 16 + (c8 & 1) * 8); }
    for (int i = tid; i < 80 * 32; i += NWAVES * 64) {
        const int rr = i >> 5, c8 = i & 31, row = row0 - 8 + rr;
        v4u v = (v4u){0u, 0u, 0u, 0u};
        if (row >= seq0 && row < seq0 + nseq) v = *(const v4u*)(p.pb() + (size_t)row * 256 + c8 * 8);
        *(LAS v4u*)(PW + rr * U_LD + c8 * 8) = v;
    }
    __syncthreads();
#pragma unroll 1
    for (int gg = 0; gg < 2; ++gg) {
        const int g = wave * 2 + gg;
        const int cbf = (l * 2 + 0) * 16 + g, cbb = (l * 2 + 1) * 16 + g;
        pg8::f32x4 acc[4];
#pragma unroll
        for (int nt = 0; nt < 4; ++nt) acc[nt] = (pg8::f32x4){0.f, 0.f, 0.f, 0.f};
        const bf16_t* kf = p.ssm_km() + (((size_t)cbf * 64 + (fq >> 1)) * 16 + fr) * 16 + (fq & 1) * 8;
        const bf16_t* kb = p.ssm_km() + (((size_t)cbb * 64 + (fq >> 1)) * 16 + fr) * 16 + (fq & 1) * 8;
        const LAS bf16_t* ucol = U + g * 16 + (fq & 1) * 8;
        bf16x8 afr[4], abr[4];
#pragma unroll
        for (int i = 0; i < 4; ++i) { afr[i] = *(const bf16x8*)(kf + (size_t)(2 * i) * 256); abr[i] = *(const bf16x8*)(kb + (size_t)(2 * i) * 256); }
#pragma unroll 1
        for (int ks0 = 0; ks0 < 32; ks0 += 4) {
#pragma unroll
            for (int i = 0; i < 4; ++i) {
                const int ks = ks0 + i;
                const bf16x8 af = afr[i], ab = abr[i];
                if (ks + 4 < 32) { afr[i] = *(const bf16x8*)(kf + (size_t)(2 * (ks + 4)) * 256); abr[i] = *(const bf16x8*)(kb + (size_t)(2 * (ks + 4)) * 256); }
                const int j = 2 * ks + (fq >> 1);
#pragma unroll
                for (int nt = 0; nt < 4; ++nt) {
                    const int t = 16 * nt + fr;
                    if (ks < 8 * nt + 8) {
                        const int rr = t - j; const int rc = rr < 0 ? 0 : rr;
                        bf16x8 bv = *(const LAS bf16x8*)(ucol + rc * U_LD);
                        if (rr < 0) bv = (bf16x8){0, 0, 0, 0, 0, 0, 0, 0};
                        acc[nt] = __builtin_amdgcn_mfma_f32_16x16x32_bf16(af, bv, acc[nt], 0, 0, 0);
                    }
                    if (ks < 32 - 8 * nt) {
                        const int rr = t + j; const int rc = rr > 63 ? 63 : rr;
                        bf16x8 bv = *(const LAS bf16x8*)(ucol + rc * U_LD);
                        if (rr > 63) bv = (bf16x8){0, 0, 0, 0, 0, 0, 0, 0};
                        acc[nt] = __builtin_amdgcn_mfma_f32_16x16x32_bf16(ab, bv, acc[nt], 0, 0, 0);
                    }
                }
            }
        }
        const int ch = g * 16 + 4 * fq;
        const pg8::f32x4 d4 = *(const pg8::f32x4*)(p.sp_ssmd() + l * SSM_W + ch);
#pragma unroll
        for (int nt = 0; nt < 4; ++nt) {
            const int t = 16 * nt + fr;
            const pg8::f32x4 y0 = *(const pg8::f32x4*)(p.yc() + ((size_t)(row0 + t)) * 256 + ch);
            const pg8::f32x4 y1 = *(const pg8::f32x4*)(p.yc() + ((size_t)R + row0 + t) * 256 + ch);
            const v2u uu = *(const LAS v2u*)(U + t * U_LD + ch);
            const float u0 = __uint_as_float(uu.x << 16), u1 = __uint_as_float(uu.x & 0xffff0000u), u2 = __uint_as_float(uu.y << 16), u3 = __uint_as_float(uu.y & 0xffff0000u);
            const float v0 = gelu_exact(acc[nt][0] + y0[0] + y1[0] + d4[0] * u0), v1 = gelu_exact(acc[nt][1] + y0[1] + y1[1] + d4[1] * u1);
            const float v2 = gelu_exact(acc[nt][2] + y0[2] + y1[2] + d4[2] * u2), v3 = gelu_exact(acc[nt][3] + y0[3] + y1[3] + d4[3] * u3);
            v2u w; w.x = pkbf(v0, v1); w.y = pkbf(v2, v3);
            *(LAS v2u*)(YG + t * U_LD + ch) = w;
        }
    }
    {
        const int tabs0 = row0 - seq0;
#pragma unroll 1
        for (int it = 0; it < 4; ++it) {
            const int idx = tid + it * (NWAVES * 64), t = idx >> 5, oc = idx & 31, gi = oc >> 3, half = 1 << gi;
            const int ta = tabs0 + t;
            int lo = ta - half; lo = lo < 0 ? 0 : lo; int hi = ta + half; hi = hi > nseq ? nseq : hi;
            float sacc[8] = {0.f, 0.f, 0.f, 0.f, 0.f, 0.f, 0.f, 0.f};
            for (int a = lo; a < hi; ++a) {
                const v4u v = *(const LAS v4u*)(PW + (a - tabs0 + 8) * U_LD + oc * 8);
                sacc[0] += __uint_as_float(v.x << 16); sacc[1] += __uint_as_float(v.x & 0xffff0000u); sacc[2] += __uint_as_float(v.y << 16); sacc[3] += __uint_as_float(v.y & 0xffff0000u);
                sacc[4] += __uint_as_float(v.z << 16); sacc[5] += __uint_as_float(v.z & 0xffff0000u); sacc[6] += __uint_as_float(v.w << 16); sacc[7] += __uint_as_float(v.w & 0xffff0000u);
            }
            const float rc = 1.0f / (float)(hi - lo);
            const v4u c = *(const LAS v4u*)(PW + (t + 8) * U_LD + oc * 8);
            v4u o;
            o.x = pkbf(sacc[0] * rc - __uint_as_float(c.x << 16), sacc[1] * rc - __uint_as_float(c.x & 0xffff0000u));
            o.y = pkbf(sacc[2] * rc - __uint_as_float(c.y << 16), sacc[3] * rc - __uint_as_float(c.y & 0xffff0000u));
            o.z = pkbf(sacc[4] * rc - __uint_as_float(c.z << 16), sacc[5] * rc - __uint_as_float(c.z & 0xffff0000u));
            o.w = pkbf(sacc[6] * rc - __uint_as_float(c.w << 16), sacc[7] * rc - __uint_as_float(c.w & 0xffff0000u));
            *(LAS v4u*)(DF + t * U_LD + oc * 8) = o;
        }
    }
    __syncthreads();
    {
        const bf16_t* wg = p.wglu_t() + (size_t)l * SSM_W * SSM_W;
#pragma unroll 1
        for (int jj = 0; jj < 2; ++jj) {
            const int jt = wave * 2 + jj;
            pg8::f32x4 acc[4];
#pragma unroll
            for (int nt = 0; nt < 4; ++nt) acc[nt] = (pg8::f32x4){0.f, 0.f, 0.f, 0.f};
#pragma unroll 2
            for (int ks = 0; ks < 8; ++ks) {
                const bf16x8 a = *(const bf16x8*)(wg + (size_t)(16 * jt + fr) * SSM_W + ks * 32 + fq * 8);
#pragma unroll
                for (int nt = 0; nt < 4; ++nt) {
                    const bf16x8 bv = *(const LAS bf16x8*)(YG + (16 * nt + fr) * U_LD + ks * 32 + fq * 8);
                    acc[nt] = __builtin_amdgcn_mfma_f32_16x16x32_bf16(a, bv, acc[nt], 0, 0, 0);
                }
            }
#pragma unroll
            for (int nt = 0; nt < 4; ++nt) {
                const int t = 16 * nt + fr, j0 = 16 * jt + 4 * fq;
                const v2u yy = *(const LAS v2u*)(YG + t * U_LD + j0);
                const float y0 = __uint_as_float(yy.x << 16), y1 = __uint_as_float(yy.x & 0xffff0000u), y2 = __uint_as_float(yy.y << 16), y3 = __uint_as_float(yy.y & 0xffff0000u);
                v2u w;
                w.x = pkbf(y0 / (1.0f + __expf(-acc[nt][0])), y1 / (1.0f + __expf(-acc[nt][1])));
                w.y = pkbf(y2 / (1.0f + __expf(-acc[nt][2])), y3 / (1.0f + __expf(-acc[nt][3])));
                *(v2u*)(p.mixb() + (size_t)(row0 + t) * D + 512 + j0) = w;
            }
        }
    }
    {
        const int gi = wave >> 1;
        const bf16_t* wp = p.poolw_t() + ((size_t)(l * 4 + gi) * 64) * 64;
#pragma unroll 1
        for (int ee = 0; ee < 2; ++ee) {
            const int et = (wave & 1) * 2 + ee;
            pg8::f32x4 acc[4];
#pragma unroll
            for (int nt = 0; nt < 4; ++nt) acc[nt] = (pg8::f32x4){0.f, 0.f, 0.f, 0.f};
#pragma unroll
            for (int ks = 0; ks < 2; ++ks) {
                const bf16x8 a = *(const bf16x8*)(wp + (size_t)(16 * et + fr) * 64 + ks * 32 + fq * 8);
#pragma unroll
                for (int nt = 0; nt < 4; ++nt) {
                    const bf16x8 bv = *(const LAS bf16x8*)(DF + (16 * nt + fr) * U_LD + gi * 64 + ks * 32 + fq * 8);
                    acc[nt] = __builtin_amdgcn_mfma_f32_16x16x32_bf16(a, bv, acc[nt], 0, 0, 0);
                }
            }
            const int e0 = gi * 64 + 16 * et + 4 * fq;
            const pg8::f32x4 sc = *(const pg8::f32x4*)(p.sp_poolsc() + l * POOL_W + e0);
#pragma unroll
            for (int nt = 0; nt < 4; ++nt) {
                const int t = 16 * nt + fr;
                v2u w; w.x = pkbf(acc[nt][0] * sc[0], acc[nt][1] * sc[1]); w.y = pkbf(acc[nt][2] * sc[2], acc[nt][3] * sc[3]);
                *(v2u*)(p.mixb() + (size_t)(row0 + t) * D + 768 + e0) = w;
            }
        }
    }
    __syncthreads();
}

__device__ __forceinline__ unsigned f2ord(float f) { const unsigned b = __float_as_uint(f); return b ^ ((unsigned)((int)b >> 31) | 0x80000000u); }
__device__ __forceinline__ float ord2f(unsigned u) { const unsigned b = (u & 0x80000000u) ? (u ^ 0x80000000u) : ~u; return __uint_as_float(b); }
__device__ __forceinline__ void ce_desc(unsigned& a, unsigned& b) { const unsigned mx = a > b ? a : b, mn = a > b ? b : a; a = mx; b = mn; }
__device__ __forceinline__ void sort16_desc(unsigned (&v)[16]) {
#pragma unroll
    for (int k = 2; k <= 16; k <<= 1)
#pragma unroll
        for (int j = k >> 1; j > 0; j >>= 1)
#pragma unroll
            for (int i = 0; i < 16; ++i) {
                const int lth = i ^ j;
                if (lth > i) { if ((i & k) == 0) ce_desc(v[i], v[lth]); else ce_desc(v[lth], v[i]); }
            }
}
__device__ __forceinline__ void merge16_desc(unsigned (&a)[16], const unsigned (&b)[16]) {
#pragma unroll
    for (int i = 0; i < 16; ++i) a[i] = a[i] > b[15 - i] ? a[i] : b[15 - i];
#pragma unroll
    for (int j = 8; j > 0; j >>= 1)
#pragma unroll
        for (int i = 0; i < 16; ++i) { const int lth = i ^ j; if (lth > i) ce_desc(a[i], a[lth]); }
}
__device__ __forceinline__ unsigned swap32u(unsigned v) {
    auto rr = __builtin_amdgcn_permlane32_swap(v, v, false, false);
    return (threadIdx.x & 32) ? rr[0] : rr[1];
}

__device__ __forceinline__ void peer_score_tile(const P& p, int l, int row0, int rmax, LAS unsigned char* lds, LAS unsigned short* eid, LAS float* gw) {
    const int tid = opaque_tid(), lane = tid & 63, r = lane & 31, h = lane >> 5;
    const int hd = __builtin_amdgcn_readfirstlane(tid >> 6);
    int row = row0 + r; row = row < rmax ? row : rmax - 1;
    unsigned top[2][16];
    bf16x8 qf[2][8];
    {
        const bf16_t* qp = p.qpb() + (size_t)row * (PH * QD) + hd * QD + h * 8;
#pragma unroll
        for (int c = 0; c < 2; ++c)
#pragma unroll
            for (int ks = 0; ks < 8; ++ks) qf[c][ks] = *(const bf16x8*)(qp + c * KD + ks * 16);
    }
#pragma unroll
    for (int c = 0; c < 2; ++c) {
        f32x16 acc[4];
#pragma unroll
        for (int nb = 0; nb < 4; ++nb)
#pragma unroll
            for (int i = 0; i < 16; ++i) acc[nb][i] = 0.f;
        const bf16_t* kp = p.keysb() + (size_t)((l * PH + hd) * 2 + c) * NK * KD + lane * 8;
#pragma unroll
        for (int ks = 0; ks < 8; ++ks) {
#pragma unroll
            for (int nb = 0; nb < 4; ++nb) {
                const bf16x8 kf = *(const bf16x8*)(kp + (nb * 8 + ks) * 512);
                acc[nb] = __builtin_amdgcn_mfma_f32_32x32x16_bf16(kf, qf[c][ks], acc[nb], 0, 0, 0);
            }
        }
        unsigned cur[16];
#pragma unroll
        for (int nb = 0; nb < 4; ++nb) {
            unsigned v[16];
#pragma unroll
            for (int i = 0; i < 16; ++i) { const int nk = 32 * nb + (i & 3) + 8 * (i >> 2) + 4 * h; v[i] = (f2ord(acc[nb][i]) & ~0x7Fu) | (unsigned)(127 - nk); }
            sort16_desc(v);
            if (nb == 0) {
#pragma unroll
                for (int i = 0; i < 16; ++i) cur[i] = v[i];
            } else merge16_desc(cur, v);
        }
        unsigned oth[16];
#pragma unroll
        for (int i = 0; i < 16; ++i) oth[i] = swap32u(cur[i]);
        merge16_desc(cur, oth);
#pragma unroll
        for (int i = 0; i < 16; ++i) top[c][i] = cur[i];
    }
    float va[16], vb[16];
#pragma unroll
    for (int i = 0; i < 16; ++i) { va[i] = ord2f(top[0][i] & ~0x7Fu); vb[i] = ord2f(top[1][i] & ~0x7Fu); }
#define PEER_CAND(a, b) ((f2ord(va[a] + vb[b]) & ~0xFFu) | (unsigned)(255 - (16 * (a) + (b))))
    unsigned best[16], g1[16], g2[16];
#pragma unroll
    for (int b = 0; b < 16; ++b) best[b] = PEER_CAND(0, b);
#pragma unroll
    for (int b = 0; b < 8; ++b) g1[b] = PEER_CAND(1, b);
#pragma unroll
    for (int b = 0; b < 5; ++b) g1[8 + b] = PEER_CAND(2, b);
#pragma unroll
    for (int b = 0; b < 3; ++b) g1[13 + b] = PEER_CAND(3, b);
    g2[0] = PEER_CAND(3, 3);
#pragma unroll
    for (int b = 0; b < 3; ++b) g2[1 + b] = PEER_CAND(4, b);
#pragma unroll
    for (int a = 5; a < 8; ++a) { g2[4 + 2 * (a - 5)] = PEER_CAND(a, 0); g2[5 + 2 * (a - 5)] = PEER_CAND(a, 1); }
#pragma unroll
    for (int a = 8; a < 14; ++a) g2[10 + (a - 8)] = PEER_CAND(a, 0);
    sort16_desc(g1); merge16_desc(best, g1);
    sort16_desc(g2); merge16_desc(best, g2);
    {
        unsigned x = PEER_CAND(14, 0);
#pragma unroll
        for (int i = 0; i < 16; ++i) ce_desc(best[i], x);
        x = PEER_CAND(15, 0);
#pragma unroll
        for (int i = 0; i < 16; ++i) ce_desc(best[i], x);
    }
#undef PEER_CAND
    LAS unsigned char* tab = lds + hd * 1024 + r * 32;
    if (h == 0) {
#pragma unroll
        for (int i = 0; i < 16; ++i) { tab[i] = (unsigned char)(127 - (top[0][i] & 0x7F)); tab[16 + i] = (unsigned char)(127 - (top[1][i] & 0x7F)); }
    }
    asm volatile("s_waitcnt lgkmcnt(0)" ::: "memory");
    float bv[16], den = 0.f;
    const float b0 = ord2f(best[0] & ~0xFFu);
#pragma unroll
    for (int k = 0; k < 16; ++k) { bv[k] = __expf(ord2f(best[k] & ~0xFFu) - b0); den += bv[k]; }
    const float rden = 1.0f / den;
    if (h == 0) {
#pragma unroll
        for (int k = 0; k < 16; ++k) {
            const int pos = 255 - (int)(best[k] & 0xFF);
            const int e = (int)tab[pos >> 4] * NK + (int)tab[16 + (pos & 15)];
            eid[r * 128 + hd * 16 + k] = (unsigned short)e;
            gw[r * 128 + hd * 16 + k] = bv[k] * rden;
        }
    }
}

__device__ __forceinline__ float dot2bf(unsigned a, unsigned b, float acc) { asm("v_dot2c_f32_bf16 %0, %1, %2" : "+v"(acc) : "v"(a), "v"(b)); return acc; }
__device__ __forceinline__ float dot8(const v4u& a, const v4u& b, float acc) {
    acc = dot2bf(a.x, b.x, acc); acc = dot2bf(a.y, b.y, acc); acc = dot2bf(a.z, b.z, acc); acc = dot2bf(a.w, b.w, acc); return acc;
}
__device__ __forceinline__ void fma8(float (&y)[8], const v4u& v, float a) {
    y[0] += a * __uint_as_float(v.x << 16); y[1] += a * __uint_as_float(v.x & 0xffff0000u);
    y[2] += a * __uint_as_float(v.y << 16); y[3] += a * __uint_as_float(v.y & 0xffff0000u);
    y[4] += a * __uint_as_float(v.z << 16); y[5] += a * __uint_as_float(v.z & 0xffff0000u);
    y[6] += a * __uint_as_float(v.w << 16); y[7] += a * __uint_as_float(v.w & 0xffff0000u);
}

__device__ __forceinline__ void sort512_asc(unsigned (&v)[8], int lane) {
#pragma unroll
    for (int k = 2; k <= 512; k <<= 1) {
#pragma unroll
        for (int j = k >> 1; j > 0; j >>= 1) {
            if (j >= 8) {
                const int lm = j >> 3;
                const bool asc = ((lane & (k >> 3)) == 0) || (k == 512);
                const bool keep_min = asc == ((lane & lm) == 0);
#pragma unroll
                for (int i = 0; i < 8; ++i) {
                    const unsigned o = (unsigned)__shfl_xor((int)v[i], lm);
                    const unsigned mn = v[i] < o ? v[i] : o, mx = v[i] < o ? o : v[i];
                    v[i] = keep_min ? mn : mx;
                }
            } else {
#pragma unroll
                for (int i = 0; i < 8; ++i) {
                    const int i2 = i ^ j;
                    if (i2 > i) {
                        const unsigned mn = v[i] < v[i2] ? v[i] : v[i2], mx = v[i] < v[i2] ? v[i2] : v[i];
                        bool asc;
                        if (k <= 4) asc = ((i & k) == 0); else if (k == 8) asc = ((lane & 1) == 0); else asc = ((lane & (k >> 3)) == 0) || (k == 512);
                        v[i] = asc ? mn : mx; v[i2] = asc ? mx : mn;
                    }
                }
            }
        }
    }
}
__device__ __forceinline__ float sum16(float v) { v += __shfl_xor(v, 8); v += __shfl_xor(v, 4); v += __shfl_xor(v, 2); v += __shfl_xor(v, 1); return v; }

typedef float f32x2 __attribute__((ext_vector_type(2)));
__device__ __forceinline__ void cvt16(const v4u& w, f32x2 (&o)[8]) {
    o[0] = __builtin_amdgcn_cvt_pk_f32_fp8((int)w.x, false); o[1] = __builtin_amdgcn_cvt_pk_f32_fp8((int)w.x, true);
    o[2] = __builtin_amdgcn_cvt_pk_f32_fp8((int)w.y, false); o[3] = __builtin_amdgcn_cvt_pk_f32_fp8((int)w.y, true);
    o[4] = __builtin_amdgcn_cvt_pk_f32_fp8((int)w.z, false); o[5] = __builtin_amdgcn_cvt_pk_f32_fp8((int)w.z, true);
    o[6] = __builtin_amdgcn_cvt_pk_f32_fp8((int)w.w, false); o[7] = __builtin_amdgcn_cvt_pk_f32_fp8((int)w.w, true);
}
__device__ __forceinline__ void peer_apply_wave(const P& p, int l, int row0, const LAS unsigned short* eid4, const LAS float* gw4, LAS unsigned* sk, LAS float* av, int lane) {
    const unsigned char* U = p.u8() + (size_t)l * NK * NK * D;
    const unsigned char* V = p.v8() + (size_t)l * NK * NK * D;
    const int li = lane & 15, tg = lane >> 4, row = row0 + tg;
    {
        unsigned key[8];
        const v4u ev = *(const LAS v4u*)(eid4 + lane * 8);
        const unsigned ee[4] = {ev.x, ev.y, ev.z, ev.w};
#pragma unroll
        for (int i = 0; i < 8; ++i) { const unsigned e = (ee[i >> 1] >> ((i & 1) * 16)) & 0xffffu, n = (unsigned)(lane * 8 + i); key[i] = ((n >> 7) << 23) | (e << 9) | n; }
        sort512_asc(key, lane);
        *(LAS v4u*)(sk + lane * 8) = (v4u){key[0], key[1], key[2], key[3]};
        *(LAS v4u*)(sk + lane * 8 + 4) = (v4u){key[4], key[5], key[6], key[7]};
    }
    asm volatile("s_waitcnt lgkmcnt(0)" ::: "memory");
    const LAS unsigned* skt = sk + tg * 128;
    {
        f32x2 h[4][8];
#pragma unroll
        for (int c = 0; c < 4; ++c) {
            const v4u w0 = *(const v4u*)(p.hb() + (size_t)row * D + 256 * c + 16 * li), w1 = *(const v4u*)(p.hb() + (size_t)row * D + 256 * c + 16 * li + 8);
            const unsigned ww[8] = {w0.x, w0.y, w0.z, w0.w, w1.x, w1.y, w1.z, w1.w};
#pragma unroll
            for (int i = 0; i < 8; ++i) h[c][i] = (f32x2){__uint_as_float(ww[i] << 16), __uint_as_float(ww[i] & 0xffff0000u)};
        }
#pragma unroll 1
        for (int j = 0; j < 128; j += 4) {
            unsigned k[4]; v4u r[4][4];
#pragma unroll
            for (int q = 0; q < 4; ++q) {
                k[q] = skt[j + q];
                const unsigned char* ur = U + (size_t)((k[q] >> 9) & 0x3fffu) * D + 16 * li;
#pragma unroll
                for (int c = 0; c < 4; ++c) r[q][c] = *(const v4u*)(ur + 256 * c);
            }
            float d[4];
#pragma unroll
            for (int q = 0; q < 4; ++q) {
                f32x2 acc = (f32x2){0.f, 0.f};
#pragma unroll
                for (int c = 0; c < 4; ++c) { f32x2 f[8]; cvt16(r[q][c], f);
#pragma unroll
                    for (int i = 0; i < 8; ++i) acc += f[i] * h[c][i]; }
                d[q] = sum16(acc.x + acc.y) * (1.0f / U8_SCALE);
            }
            if (li == 0) {
#pragma unroll
                for (int q = 0; q < 4; ++q) { const int s0 = (int)(k[q] & 511u); av[s0] = gelu_exact(d[q]) * gw4[s0] * (1.0f / V8_SCALE); }
            }
        }
    }
    asm volatile("s_waitcnt lgkmcnt(0)" ::: "memory");
    f32x2 y[4][8];
#pragma unroll
    for (int c = 0; c < 4; ++c)
#pragma unroll
        for (int i = 0; i < 8; ++i) y[c][i] = (f32x2){0.f, 0.f};
#pragma unroll 1
    for (int j = 0; j < 128; j += 4) {
        unsigned k[4]; v4u r[4][4]; float a[4];
#pragma unroll
        for (int q = 0; q < 4; ++q) {
            k[q] = skt[j + q];
            const unsigned char* vr = V + (size_t)((k[q] >> 9) & 0x3fffu) * D + 16 * li;
#pragma unroll
            for (int c = 0; c < 4; ++c) r[q][c] = *(const v4u*)(vr + 256 * c);
            a[q] = av[k[q] & 511u];
        }
#pragma unroll
        for (int q = 0; q < 4; ++q)
#pragma unroll
            for (int c = 0; c < 4; ++c) { f32x2 f[8]; cvt16(r[q][c], f);
#pragma unroll
                for (int i = 0; i < 8; ++i) y[c][i] += f[i] * a[q]; }
    }
    const int ms = modset(row);
    const float* m5 = p.mod() + ((size_t)l * 3 + ms) * (NMOD * D) + 5 * D;
    float* xr = p.xb() + (size_t)row * D;
    float ss = 0.f;
#pragma unroll
    for (int c = 0; c < 4; ++c)
#pragma unroll
        for (int q = 0; q < 4; ++q) {
            const f32x4 xa = *(const f32x4*)(xr + 256 * c + 16 * li + 4 * q), ma = *(const f32x4*)(m5 + 256 * c + 16 * li + 4 * q);
            const float x0 = xa[0] + ma[0] * y[c][2 * q].x, x1 = xa[1] + ma[1] * y[c][2 * q].y, x2 = xa[2] + ma[2] * y[c][2 * q + 1].x, x3 = xa[3] + ma[3] * y[c][2 * q + 1].y;
            y[c][2 * q] = (f32x2){x0, x1}; y[c][2 * q + 1] = (f32x2){x2, x3};
            ss += (x0 * x0 + x1 * x1) + (x2 * x2 + x3 * x3);
        }
    ss = sum16(ss);
    const float rn = rsqrtf(ss * (1.0f / D) + EPS);
    if (l + 1 < DEPTH) {
        const float* g = p.sp_n1g() + (l + 1) * D;
        const float* mn = p.mod() + ((size_t)(l + 1) * 3 + ms) * (NMOD * D);
#pragma unroll
        for (int c = 0; c < 4; ++c) {
            const int k0 = 256 * c + 16 * li;
            unsigned o[8];
#pragma unroll
            for (int q = 0; q < 4; ++q) {
                *(f32x4*)(xr + k0 + 4 * q) = (f32x4){y[c][2 * q].x, y[c][2 * q].y, y[c][2 * q + 1].x, y[c][2 * q + 1].y};
                const f32x4 gg = *(const f32x4*)(g + k0 + 4 * q), sh = *(const f32x4*)(mn + k0 + 4 * q), sc = *(const f32x4*)(mn + D + k0 + 4 * q);
                o[2 * q] = pkbf(y[c][2 * q].x * rn * gg[0] * (1.0f + sc[0]) + sh[0], y[c][2 * q].y * rn * gg[1] * (1.0f + sc[1]) + sh[1]);
                o[2 * q + 1] = pkbf(y[c][2 * q + 1].x * rn * gg[2] * (1.0f + sc[2]) + sh[2], y[c][2 * q + 1].y * rn * gg[3] * (1.0f + sc[3]) + sh[3]);
            }
            *(v4u*)(p.hb() + (size_t)row * D + k0) = (v4u){o[0], o[1], o[2], o[3]};
            *(v4u*)(p.hb() + (size_t)row * D + k0 + 8) = (v4u){o[4], o[5], o[6], o[7]};
        }
    } else {
        const float* g = p.sp_fing();
        float* orow = p.out() + (size_t)row * D;
#pragma unroll
        for (int c = 0; c < 4; ++c)
#pragma unroll
            for (int q = 0; q < 4; ++q) {
                const int k0 = 256 * c + 16 * li + 4 * q;
                const f32x4 gg = *(const f32x4*)(g + k0);
                *(f32x4*)(orow + k0) = (f32x4){y[c][2 * q].x * rn * gg[0], y[c][2 * q].y * rn * gg[1], y[c][2 * q + 1].x * rn * gg[2], y[c][2 * q + 1].y * rn * gg[3]};
            }
    }
}

__device__ __forceinline__ void peer_apply_token64(const P& p, int l, int row, const LAS unsigned short* eid, const LAS float* gw, LAS float* av, int lane) {
    const unsigned char* U = p.u8() + (size_t)l * NK * NK * D + 16 * lane;
    const unsigned char* V = p.v8() + (size_t)l * NK * NK * D + 16 * lane;
    f32x2 h[8];
    {
        const v4u w0 = *(const v4u*)(p.hb() + (size_t)row * D + 16 * lane), w1 = *(const v4u*)(p.hb() + (size_t)row * D + 16 * lane + 8);
        const unsigned ww[8] = {w0.x, w0.y, w0.z, w0.w, w1.x, w1.y, w1.z, w1.w};
#pragma unroll
        for (int i = 0; i < 8; ++i) h[i] = (f32x2){__uint_as_float(ww[i] << 16), __uint_as_float(ww[i] & 0xffff0000u)};
    }
#pragma unroll 1
    for (int j0 = 0; j0 < 128; j0 += 16) {
        v4u r[16];
#pragma unroll
        for (int q = 0; q < 16; ++q) { const int e = __builtin_amdgcn_readfirstlane((int)eid[j0 + q]); r[q] = *(const v4u*)(U + (size_t)e * D); }
        float d[16];
#pragma unroll
        for (int q = 0; q < 16; ++q) { f32x2 f[8]; cvt16(r[q], f); f32x2 acc = f[0] * h[0];
#pragma unroll
            for (int k = 1; k < 8; ++k) acc += f[k] * h[k];
            d[q] = acc.x + acc.y; }
        float w8[8], w4[4], w2[2], w1;
#pragma unroll
        for (int i = 0; i < 8; ++i) { const float keep = (lane & 32) ? d[i + 8] : d[i], send = (lane & 32) ? d[i] : d[i + 8]; w8[i] = keep + __shfl_xor(send, 32); }
#pragma unroll
        for (int i = 0; i < 4; ++i) { const float keep = (lane & 16) ? w8[i + 4] : w8[i], send = (lane & 16) ? w8[i] : w8[i + 4]; w4[i] = keep + __shfl_xor(send, 16); }
#pragma unroll
        for (int i = 0; i < 2; ++i) { const float keep = (lane & 8) ? w4[i + 2] : w4[i], send = (lane & 8) ? w4[i] : w4[i + 2]; w2[i] = keep + __shfl_xor(send, 8); }
        { const float keep = (lane & 4) ? w2[1] : w2[0], send = (lane & 4) ? w2[0] : w2[1]; w1 = keep + __shfl_xor(send, 4); }
        w1 += __shfl_xor(w1, 2); w1 += __shfl_xor(w1, 1);
        const int hit = j0 + ((lane >> 5) & 1) * 8 + ((lane >> 4) & 1) * 4 + ((lane >> 3) & 1) * 2 + ((lane >> 2) & 1);
        if ((lane & 3) == 0) av[hit] = gelu_exact(w1 * (1.0f / U8_SCALE)) * gw[hit] * (1.0f / V8_SCALE);
    }
    asm volatile("s_waitcnt lgkmcnt(0)" ::: "memory");
    f32x2 y[8];
#pragma unroll
    for (int k = 0; k < 8; ++k) y[k] = (f32x2){0.f, 0.f};
#pragma unroll 1
    for (int j0 = 0; j0 < 128; j0 += 16) {
        v4u r[16]; float a[16];
#pragma unroll
        for (int q = 0; q < 16; ++q) { const int e = __builtin_amdgcn_readfirstlane((int)eid[j0 + q]); r[q] = *(const v4u*)(V + (size_t)e * D); a[q] = av[j0 + q]; }
#pragma unroll
        for (int q = 0; q < 16; ++q) { f32x2 f[8]; cvt16(r[q], f);
#pragma unroll
            for (int k = 0; k < 8; ++k) y[k] += f[k] * a[q]; }
    }
    const int ms = modset(row);
    const float* m5 = p.mod() + ((size_t)l * 3 + ms) * (NMOD * D) + 5 * D + 16 * lane;
    float* xr = p.xb() + (size_t)row * D + 16 * lane;
    float xn[16]; float ss = 0.f;
#pragma unroll
    for (int q = 0; q < 4; ++q) {
        const f32x4 xa = *(const f32x4*)(xr + 4 * q), ma = *(const f32x4*)(m5 + 4 * q);
        xn[4 * q] = xa[0] + ma[0] * y[2 * q].x; xn[4 * q + 1] = xa[1] + ma[1] * y[2 * q].y; xn[4 * q + 2] = xa[2] + ma[2] * y[2 * q + 1].x; xn[4 * q + 3] = xa[3] + ma[3] * y[2 * q + 1].y;
        ss += (xn[4 * q] * xn[4 * q] + xn[4 * q + 1] * xn[4 * q + 1]) + (xn[4 * q + 2] * xn[4 * q + 2] + xn[4 * q + 3] * xn[4 * q + 3]);
    }
    ss = wave_sum(ss);
    const float rn = rsqrtf(ss * (1.0f / D) + EPS);
    const float* g = p.sp_n1g() + (l + 1) * D + 16 * lane;
    const float* mn = p.mod() + ((size_t)(l + 1) * 3 + ms) * (NMOD * D) + 16 * lane;
    unsigned o[8];
#pragma unroll
    for (int q = 0; q < 4; ++q) {
        *(f32x4*)(xr + 4 * q) = (f32x4){xn[4 * q], xn[4 * q + 1], xn[4 * q + 2], xn[4 * q + 3]};
        const f32x4 gg = *(const f32x4*)(g + 4 * q), sh = *(const f32x4*)(mn + 4 * q), sc = *(const f32x4*)(mn + D + 4 * q);
        o[2 * q] = pkbf(xn[4 * q] * rn * gg[0] * (1.0f + sc[0]) + sh[0], xn[4 * q + 1] * rn * gg[1] * (1.0f + sc[1]) + sh[1]);
        o[2 * q + 1] = pkbf(xn[4 * q + 2] * rn * gg[2] * (1.0f + sc[2]) + sh[2], xn[4 * q + 3] * rn * gg[3] * (1.0f + sc[3]) + sh[3]);
    }
    *(v4u*)(p.hb() + (size_t)row * D + 16 * lane) = (v4u){o[0], o[1], o[2], o[3]};
    *(v4u*)(p.hb() + (size_t)row * D + 16 * lane + 8) = (v4u){o[4], o[5], o[6], o[7]};
}


template <class EpiF>
__device__ __forceinline__ void ctx_gemm(const bf16_t* A, const bf16_t* Bt, int N, LAS unsigned char* lds, const EpiF& epi) {
    const int tid = opaque_tid(), lane = tid & 63, fr = lane & 15, fq = lane >> 4;
    const int wave = __builtin_amdgcn_readfirstlane(tid >> 6), wr = wave >> 2, wc = wave & 3;
    constexpr int KC = 256, LD = KC * 2 + 16;
    constexpr int ABYTES = 32 * LD, BUF = (32 + 64) * LD;
    const int npc = N / 64, G = gridDim.x;
    for (int piece = blockIdx.x; piece < 16 * npc; piece += G) {
        const int pr = piece / npc, pc = piece - pr * npc;
        const bf16_t* ga[2]; const bf16_t* gb[4]; int la[2], lb[4];
#pragma unroll
        for (int i = 0; i < 2; ++i) { const int id = tid + i * 512, rr = id >> 5, c = id & 31; ga[i] = A + (size_t)(pr * 32 + rr) * D + c * 8; la[i] = rr * LD + c * 16; }
#pragma unroll
        for (int i = 0; i < 4; ++i) { const int id = tid + i * 512, rr = id >> 5, c = id & 31; gb[i] = Bt + (size_t)(pc * 64 + rr) * D + c * 8; lb[i] = ABYTES + rr * LD + c * 16; }
        v4u ra[2], rb[4];
#pragma unroll
        for (int i = 0; i < 2; ++i) ra[i] = *(const v4u*)ga[i];
#pragma unroll
        for (int i = 0; i < 4; ++i) rb[i] = *(const v4u*)gb[i];
        __syncthreads();
#pragma unroll
        for (int i = 0; i < 2; ++i) *(LAS v4u*)(lds + la[i]) = ra[i];
#pragma unroll
        for (int i = 0; i < 4; ++i) *(LAS v4u*)(lds + lb[i]) = rb[i];
        __syncthreads();
        pg8::f32x4 acc = (pg8::f32x4){0.f, 0.f, 0.f, 0.f};
#pragma unroll 1
        for (int c = 0; c < D / KC; ++c) {
            const bool more = c + 1 < D / KC;
            if (more) {
#pragma unroll
                for (int i = 0; i < 2; ++i) ra[i] = *(const v4u*)(ga[i] + (c + 1) * KC);
#pragma unroll
                for (int i = 0; i < 4; ++i) rb[i] = *(const v4u*)(gb[i] + (c + 1) * KC);
            }
            const LAS unsigned char* buf = lds + (c & 1) * BUF;
            const LAS unsigned char* pa = buf + (wr * 16 + fr) * LD + fq * 16;
            const LAS unsigned char* pb = buf + ABYTES + (wc * 16 + fr) * LD + fq * 16;
#pragma unroll
            for (int ks = 0; ks < KC / 32; ++ks) {
                const bf16x8 bf = *(const LAS bf16x8*)(pb + ks * 64), af = *(const LAS bf16x8*)(pa + ks * 64);
                acc = __builtin_amdgcn_mfma_f32_16x16x32_bf16(bf, af, acc, 0, 0, 0);
            }
            if (more) {
                LAS unsigned char* nb = lds + ((c + 1) & 1) * BUF;
#pragma unroll
                for (int i = 0; i < 2; ++i) *(LAS v4u*)(nb + la[i]) = ra[i];
#pragma unroll
                for (int i = 0; i < 4; ++i) *(LAS v4u*)(nb + lb[i]) = rb[i];
            }
            __syncthreads();
        }
        epi(pr * 32 + wr * 16 + fr, pc * 64 + wc * 16 + 4 * fq, acc);
    }
}

#define XB_TMO      128
#define XB_XCNT(j)  (256  + 64 * (j))
#define XB_XSUB(j)  (1280 + 64 * (j))
#define XB_XGEN(j)  (2304 + 64 * (j))
#define XB_TOP      3328
#define XB_TOPGEN   3392
#define XCD_BAR_WORDS 3456
#define XB_UCNT(l)  (3584 + 64 * (l))
#define XB_SPIN_CAP (1u << 18)

__device__ __forceinline__ unsigned xb_ld(unsigned* p)              { return __hip_atomic_load(p, __ATOMIC_RELAXED, __HIP_MEMORY_SCOPE_AGENT); }
__device__ __forceinline__ unsigned xb_add(unsigned* p, unsigned v) { return __hip_atomic_fetch_add(p, v, __ATOMIC_RELAXED, __HIP_MEMORY_SCOPE_AGENT); }
__device__ __forceinline__ unsigned xb_xcc_id() { return (unsigned)__builtin_amdgcn_s_getreg((3 << 11) | 20) & 0xFu; }
#define XB_SPIN(cond, bar) do { unsigned _sp = 0; while (cond) { __builtin_amdgcn_s_sleep(1); \
    if ((++_sp & 255u) == 0u) { if (xb_ld(&(bar)[XB_TMO])) break; if (_sp > XB_SPIN_CAP) { atomicAdd(&(bar)[XB_TMO], 1u); break; } } } } while (0)

struct XcdBarrier {
    unsigned* bar; unsigned x;
    volatile LAS unsigned* st;
};

__device__ __forceinline__ XcdBarrier xcd_barrier_post(unsigned* bar, volatile LAS unsigned* st) {
    XcdBarrier b; b.bar = bar; b.x = xb_xcc_id(); b.st = st;
    if (threadIdx.x == 0) (void)xb_add(&bar[XB_XCNT(b.x)], 1u);
    return b;
}
__device__ __forceinline__ void xcd_barrier_complete(unsigned* bar, unsigned x, unsigned& nloc, unsigned& nx) {
    const unsigned G = gridDim.x * gridDim.y * gridDim.z;
    unsigned sum, cnt, mine, sp = 0u;
    for (;;) {
        sum = 0u; cnt = 0u; mine = 0u;
#pragma unroll
        for (unsigned j = 0; j < 16; ++j) { const unsigned c = xb_ld(&bar[XB_XCNT(j)]); sum += c; cnt += (c > 0u) ? 1u : 0u; mine = (j == x) ? c : mine; }
        if (sum == G) break;
        __builtin_amdgcn_s_sleep(1);
        if ((++sp & 255u) == 0u) { if (xb_ld(&bar[XB_TMO])) break; if (sp > XB_SPIN_CAP) { atomicAdd(&bar[XB_TMO], 1u); break; } }
    }
    nloc = mine > 0u ? mine : 1u; nx = cnt > 0u ? cnt : 1u;
}

__device__ __forceinline__ void xcd_barrier(const XcdBarrier& b) {
    asm volatile("s_waitcnt vmcnt(0)" ::: "memory");
    __syncthreads();
    if (threadIdx.x == 0) {
        unsigned* bar = b.bar;
        __builtin_amdgcn_s_waitcnt(0);
        unsigned nloc = b.st[0], nx = b.st[1];
        if (nloc == 0u) { xcd_barrier_complete(bar, b.x, nloc, nx); b.st[0] = nloc; b.st[1] = nx; }
        const unsigned old = xb_add(&bar[XB_XSUB(b.x)], 1u);
        const unsigned gen = old / nloc;
        if (old + 1u == (gen + 1u) * nloc) {
            __builtin_amdgcn_fence(__ATOMIC_RELEASE, "agent");
            asm volatile("s_waitcnt vmcnt(0)" ::: "memory");
            const unsigned og = xb_add(&bar[XB_TOP], 1u);
            const unsigned tg = og / nx;
            if (og + 1u == (tg + 1u) * nx) xb_add(&bar[XB_TOPGEN], 1u);
            else XB_SPIN(xb_ld(&bar[XB_TOPGEN]) == tg, bar);
            __builtin_amdgcn_fence(__ATOMIC_ACQUIRE, "agent");
            xb_add(&bar[XB_XGEN(b.x)], 1u);
            asm volatile("s_waitcnt vmcnt(0)" ::: "memory");
        } else {
            XB_SPIN(xb_ld(&bar[XB_XGEN(b.x)]) == gen, bar);
            __builtin_amdgcn_fence(__ATOMIC_ACQUIRE, "agent");
            asm volatile("s_waitcnt vmcnt(0)" ::: "memory");
        }
    }
    __syncthreads();
}


__device__ __forceinline__ P fresh(const P& p) { P q = p; asm volatile("" : "+s"(q.ws)); return q; }

__device__ __forceinline__ void convert_expert_tables(const P& p, int l, int ci, int nconv) {
    constexpr unsigned NL = (unsigned)((size_t)NK * NK * D / 4);
    const f32x4* su = (const f32x4*)p.pu() + (size_t)l * NL; const f32x4* sv = (const f32x4*)p.pv() + (size_t)l * NL;
    int* du = (int*)p.u8() + (size_t)l * NL; int* dv = (int*)p.v8() + (size_t)l * NL;
    const unsigned st = (unsigned)nconv * (NWAVES * 64);
    for (unsigned i0 = (unsigned)ci * (NWAVES * 64) + opaque_tid(); i0 < NL; i0 += 8 * st) {
        f32x4 a[8], b[8];
#pragma unroll
        for (int q = 0; q < 8; ++q) { const unsigned i = i0 + q * st; if (i < NL) { a[q] = __builtin_nontemporal_load(su + i); b[q] = __builtin_nontemporal_load(sv + i); } }
#pragma unroll
        for (int q = 0; q < 8; ++q) {
            const unsigned i = i0 + q * st;
            if (i < NL) {
                int wa = __builtin_amdgcn_cvt_pk_fp8_f32(a[q][0] * U8_SCALE, a[q][1] * U8_SCALE, 0, false); wa = __builtin_amdgcn_cvt_pk_fp8_f32(a[q][2] * U8_SCALE, a[q][3] * U8_SCALE, wa, true);
                int wb = __builtin_amdgcn_cvt_pk_fp8_f32(b[q][0] * V8_SCALE, b[q][1] * V8_SCALE, 0, false); wb = __builtin_amdgcn_cvt_pk_fp8_f32(b[q][2] * V8_SCALE, b[q][3] * V8_SCALE, wb, true);
                du[i] = wa; dv[i] = wb;
            }
        }
    }
}

enum { PH_PRO = 0, PH_NORM1 = 1, PH_G1 = 2, PH_ATTN = 3, PH_SSMB = 4, PH_G2 = 5, PH_NORM2 = 6, PH_G3 = 7, PH_PEER = 8, PH_PER_LAYER = 16 };
__host__ __device__ __forceinline__ int phase_id(int l, int k) { return 1 + l * PH_PER_LAYER + (k - 1); }

__global__ void __launch_bounds__(NWAVES * 64, 2) mega(P p, int ph_lo, int ph_hi) {
    extern __shared__ __attribute__((aligned(16))) unsigned char lds[];
    cg::grid_group grid = cg::this_grid();
    const int G = gridDim.x, NGW = G * NWAVES;
    const unsigned NGT = G * NWAVES * 64;
    volatile LAS unsigned* bst = (volatile LAS unsigned*)((LAS unsigned char*)lds + LDS_BYTES - 64);
    if (threadIdx.x < 2) bst[threadIdx.x] = 0u;
    __syncthreads();
    const XcdBarrier bar = xcd_barrier_post(p.ctl(), bst);
#define PHASE_COORDS const int tid = opaque_tid(), lane = tid & 63, wave = __builtin_amdgcn_readfirstlane(tid >> 6), gw = blockIdx.x * NWAVES + wave; const unsigned gtid = blockIdx.x * (NWAVES * 64) + tid; (void)lane; (void)gw; (void)gtid;
#define IN(k) (ph_lo <= (k) && (k) < ph_hi)
#define SYNC_AFTER(k) do { if ((k) + 1 < ph_hi) { if ((k) == PH_PRO) grid.sync(); else xcd_barrier(bar); } } while (0)
    if (IN(PH_PRO)) {
        {
            PHASE_COORDS
            auto convert_tables = [&]() {
            for (unsigned i0 = blockIdx.x * (NWAVES * 64) + opaque_tid(); i0 < (unsigned)((size_t)DEPTH * NK * NK * D / 4); i0 += 4 * NGT) {
                f32x4 a[4], b[4];
#pragma unroll
                for (int q = 0; q < 4; ++q) { const unsigned i = i0 + q * NGT; a[q] = __builtin_nontemporal_load((const f32x4*)p.pu() + i); b[q] = __builtin_nontemporal_load((const f32x4*)p.pv() + i); }
#pragma unroll
                for (int q = 0; q < 4; ++q) {
                    const unsigned i = i0 + q * NGT;
                    int wa = __builtin_amdgcn_cvt_pk_fp8_f32(a[q][0] * U8_SCALE, a[q][1] * U8_SCALE, 0, false); wa = __builtin_amdgcn_cvt_pk_fp8_f32(a[q][2] * U8_SCALE, a[q][3] * U8_SCALE, wa, true);
                    int wb = __builtin_amdgcn_cvt_pk_fp8_f32(b[q][0] * V8_SCALE, b[q][1] * V8_SCALE, 0, false); wb = __builtin_amdgcn_cvt_pk_fp8_f32(b[q][2] * V8_SCALE, b[q][3] * V8_SCALE, wb, true);
                    ((int*)p.u8())[i] = wa; ((int*)p.v8())[i] = wb;
                }
            }
            };
            if (G != 256 && (blockIdx.x & 1)) convert_tables();
            LAS float* scr = (LAS float*)lds + wave * (64 * 33);
            constexpr int I_IN = (D / 64) * (IN_W / 32), I_OUT = (D / 64) * (D / 32), I_Q = (D / 64) * (PH * QD / 32);
            constexpr int PER_L = I_IN + I_OUT + I_Q;
            for (int it = gw; it < DEPTH * PER_L; it += NGW) {
                const int l = it / PER_L; int r = it % PER_L;
                if (r < I_IN) { transpose_item(p.w_in() + (size_t)l * D * IN_W, D, IN_W, p.w_in_t() + (size_t)l * IN_W * D, scr, r, lane); continue; } r -= I_IN;
                if (r < I_OUT) { transpose_item(p.w_out() + (size_t)l * D * D, D, D, p.w_out_t() + (size_t)l * D * D, scr, r, lane); continue; } r -= I_OUT;
                transpose_item(p.wq() + (size_t)l * D * PH * QD, D, PH * QD, p.wq_t() + (size_t)l * PH * QD * D, scr, r, lane);
            }
            for (int it = gw; it < DEPTH * 32 + DEPTH * 4 * 2; it += NGW) {
                if (it < DEPTH * 32) { const int l = it / 32; transpose_item(p.w_glu() + (size_t)l * SSM_W * SSM_W, SSM_W, SSM_W, p.wglu_t() + (size_t)l * SSM_W * SSM_W, scr, it % 32, lane); }
                else { const int r = it - DEPTH * 32, mtx = r >> 1; transpose_item(p.pool_w() + (size_t)mtx * 64 * 64, 64, 64, p.poolw_t() + (size_t)mtx * 64 * 64, scr, r & 1, lane); }
            }
            __syncthreads();
            ssm_tables(p, (LAS unsigned char*)lds);
            {
                LAS float* sl = (LAS float*)lds + NWAVES * 64 * 33;
                __syncthreads();
                for (int i = tid; i < 3 * D; i += NWAVES * 64) { const float cv = i < 2 * D ? p.c()[i] : p.c_ctx()[i - 2 * D]; sl[i] = cv / (1.0f + __expf(-cv)); }
                __syncthreads();
                for (int it = gw; it < DEPTH * (NMOD * D / 16); it += NGW) {
                    const int l = it / (NMOD * D / 16), j = (it % (NMOD * D / 16)) * 16 + (lane & 15), k0 = (lane >> 4) * 256;
                    const float* w = p.w_mod() + (size_t)l * D * (NMOD * D) + (size_t)k0 * (NMOD * D) + j;
                    float a0 = 0.f, a1 = 0.f, a2 = 0.f;
#pragma unroll 16
                    for (int k = 0; k < 256; ++k) {
                        const float wv = w[(size_t)k * (NMOD * D)];
                        a0 += sl[k0 + k] * wv; a1 += sl[D + k0 + k] * wv; a2 += sl[2 * D + k0 + k] * wv;
                    }
                    a0 += __shfl_xor(a0, 16); a1 += __shfl_xor(a1, 16); a2 += __shfl_xor(a2, 16);
                    a0 += __shfl_xor(a0, 32); a1 += __shfl_xor(a1, 32); a2 += __shfl_xor(a2, 32);
                    if (lane < 16) {
                        const float bb = p.b_mod()[(size_t)l * NMOD * D + j];
                        float* mo = p.mod() + (size_t)l * 3 * NMOD * D + j;
                        mo[0] = a0 + bb; mo[NMOD * D] = a1 + bb; mo[2 * NMOD * D] = a2 + bb;
                    }
                }
                __syncthreads();
            }
            for (unsigned i = blockIdx.x * (NWAVES * 64) + opaque_tid(); i < (unsigned)(DEPTH * D); i += NGT) {
                p.sp_n1g()[i] = p.norm1_g()[i]; p.sp_n2g()[i] = p.norm2_g()[i];
                if (i < (unsigned)D) p.sp_fing()[i] = p.final_g()[i];
                if (i < (unsigned)(DEPTH * VD)) p.sp_subln()[i] = p.subln_g()[i];
                if (i < (unsigned)(DEPTH * SSM_W)) { p.sp_ssmd()[i] = p.ssm_d()[i]; p.sp_poolsc()[i] = p.pool_scale()[i]; }
            }
            for (unsigned i = blockIdx.x * (NWAVES * 64) + opaque_tid(); i < (size_t)64 * 64; i += NGT) {
                float lre, lim, step, cr, ci; ssm_zoh(p, (int)(i >> 6), (int)(i & 63), lre, lim, step, cr, ci);
                float ar, ai; ssm_apow(lre, lim, step, 64.0f, ar, ai);
                p.sp_a64()[i * 2] = ar; p.sp_a64()[i * 2 + 1] = ai;
            }
            if (gw < DEPTH) {
                const int l = gw;
                const float s1 = wave_sum(p.lam_q1()[l * HD + lane] * p.lam_k1()[l * HD + lane]);
                const float s2 = wave_sum(p.lam_q2()[l * HD + lane] * p.lam_k2()[l * HD + lane]);
                const float lam_init = 0.8f - 0.6f * expf(-0.3f * (float)l);
                if (lane == 0) { p.sp_lam()[l * 2] = expf(s1) - expf(s2) + lam_init; p.sp_lam()[l * 2 + 1] = lam_init; }
            }
            for (unsigned i = blockIdx.x * (NWAVES * 64) + opaque_tid(); i < (unsigned)((size_t)DEPTH * PH * 2 * NK * KD / 4); i += NGT) {
                const f32x4 v = ((const f32x4*)p.keys())[i];
                v2u w; w.x = pkbf(v[0], v[1]); w.y = pkbf(v[2], v[3]);
                const unsigned d4 = i & 31u, nk = (i >> 5) & 127u, hc = i >> 12;
                const unsigned dd = d4 * 4, ks = dd >> 4, hh = (dd >> 3) & 1u, e = dd & 7u, nb = nk >> 5, r = nk & 31u;
                const unsigned o = (((hc * 4 + nb) * 8 + ks) * 64 + hh * 32 + r) * 8 + e;
                *(v2u*)(p.keysb() + o) = w;
            }
            if (G != 256 && !(blockIdx.x & 1)) convert_tables();
            for (unsigned i = blockIdx.x * (NWAVES * 64) + opaque_tid(); i < (size_t)SEQ * 32; i += NGT) {
                const int ii = (int)(i & 15), a = (int)(i >> 4) & 1, t = (int)(i >> 5);
                const int pos = a == 0 ? t / GRIDW : t % GRIDW;
                const float inv = 1.0f / powf(10000.0f, (float)ii / 16.0f);
                const float ang = (float)pos * inv;
                p.ropet()[i * 2] = cosf(ang); p.ropet()[i * 2 + 1] = sinf(ang);
            }
        }
        SYNC_AFTER(PH_PRO);
    }
    for (int l = 0; l < DEPTH; ++l) {
        {
            const float* modl = p.mod() + (size_t)l * 3 * NMOD * D;
            if (l == 0 && IN(phase_id(l, PH_NORM1))) {
                PHASE_COORDS const P p_ = fresh(p); const float* modl_ = p_.mod() + (size_t)l * 3 * NMOD * D; (void)modl_;
                const float* xin_ = p_.x(); const float* cin_ = p_.ctx();
                normmod_rows([&](int row) { return row < RL ? xin_ + (size_t)row * D : cin_ + (size_t)(row - RL) * D; },
                             p_.sp_n1g() + l * D, modl_, 0, 1, p_.hb(), R, gw, NGW, lane);
                SYNC_AFTER(phase_id(l, PH_NORM1));
            }
            if (IN(phase_id(l, PH_G1))) {
                PHASE_COORDS const P p_ = fresh(p); const float* modl_ = p_.mod() + (size_t)l * 3 * NMOD * D; (void)modl_;
                pg8::Gemm g{p_.hb(), p_.w_in_t() + (size_t)l * IN_W * D, R, IN_W, D};
                unsigned* ucnt = p_.ctl() + XB_UCNT(l);
                pg8::InProjOrder S{G, (int)blockIdx.x, ucnt};
                EpiInProj E{p_.qb(), p_.ropet()};
                pg8::gemm_phase<EpiInProj, pg8::InProjOrder, true, true>((PG8_LAS unsigned char*)lds, g, S, E);
                {
                    const int nss = pg8::InProjOrder::n_ssm_wg(G), i0 = nss ? (int)blockIdx.x - (G - nss) : (int)blockIdx.x, st = nss ? 64 : G;
                    if (i0 >= 0 && i0 < 64) {
                        if (opaque_tid() == 0) {
                            XB_SPIN(xb_ld(ucnt) < 66u * NWAVES, p_.ctl());
                            __builtin_amdgcn_fence(__ATOMIC_ACQUIRE, "agent");
                            asm volatile("s_waitcnt vmcnt(0)" ::: "memory");
                        }
                        __syncthreads();
                        for (int i = i0; i < 64; i += st) ssm_a_item(p_, l, i >> 5, (i >> 4) & 1, i & 15, (LAS unsigned char*)lds);
                    }
                }
                if (G == 256 && l == 0) {
                    const int x = (int)blockIdx.x & 7, s_ = (int)blockIdx.x >> 3;
                    const int ci = x < 2 ? (s_ >= 16 && s_ < 24 ? x * 8 + (s_ - 16) : -1) : (s_ >= 8 && s_ < 24 ? 16 + (x - 2) * 16 + (s_ - 8) : -1);
                    if (ci >= 0) convert_expert_tables(p_, l, ci, 112);
                }
                SYNC_AFTER(phase_id(l, PH_G1));
            }
            if (IN(phase_id(l, PH_ATTN))) {
                PHASE_COORDS const P p_ = fresh(p); const float* modl_ = p_.mod() + (size_t)l * 3 * NMOD * D; (void)modl_;
                attn_phase(p_, l, (LAS unsigned char*)lds, l + 1 < DEPTH);
                for (int i = blockIdx.x; i < 256; i += G) { const int b = i >> 7, c = i & 127; ssm_b_unit(p_, l, b * SEQ + 64 * c, b * SEQ, SEQ, (LAS unsigned char*)lds); }
                if (l + 1 < DEPTH) {
                    for (int ci = (int)((blockIdx.x + (unsigned)G - 16u % (unsigned)G) % (unsigned)G); ci < 8; ci += G) { const int b = ci >> 2, c = ci & 3; ssm_b_unit(p_, l, RL + b * CTX + 64 * c, RL + b * CTX, CTX, (LAS unsigned char*)lds); }
                    if (G == 256 && blockIdx.x >= 24) convert_expert_tables(p_, l + 1, (int)blockIdx.x - 24, 232);
                }
                SYNC_AFTER(phase_id(l, PH_ATTN));
            }
            const int MR = l + 1 < DEPTH ? R : RL;
            if (IN(phase_id(l, PH_G2))) {
                PHASE_COORDS const P p_ = fresh(p); const float* modl_ = p_.mod() + (size_t)l * 3 * NMOD * D; (void)modl_;
                pg8::Gemm g{p_.mixb(), p_.w_out_t() + (size_t)l * D * D, RL, D, D};
                pg8::StaticOrder S; S.init(RL, D, G, (int)blockIdx.x);
                EpiResid E{p_.xb(), modl_, l == 0 ? p_.x() : p_.xb(), l == 0 ? p_.ctx() : p_.xb() + (size_t)RL * D};
                pg8::gemm_phase<EpiResid, pg8::StaticOrder, true, true>((PG8_LAS unsigned char*)lds, g, S, E);
                if (MR > RL) {
                    const float* gate = modl_ + (size_t)2 * (NMOD * D) + 2 * D;
                    const float* xs = l == 0 ? p_.ctx() : p_.xb() + (size_t)RL * D;
                    float* xo = p_.xb() + (size_t)RL * D;
                    ctx_gemm(p_.mixb() + (size_t)RL * D, p_.w_out_t() + (size_t)l * D * D, D, (LAS unsigned char*)lds,
                             [&](int row, int col, const pg8::f32x4& a) {
                                 const pg8::f32x4 gv = *(const pg8::f32x4*)(gate + col), xv = *(const pg8::f32x4*)(xs + (size_t)row * D + col);
                                 *(pg8::f32x4*)(xo + (size_t)row * D + col) = xv + gv * a;
                             });
                }
                SYNC_AFTER(phase_id(l, PH_G2));
            }
            if (IN(phase_id(l, PH_NORM2))) {
                PHASE_COORDS const P p_ = fresh(p); const float* modl_ = p_.mod() + (size_t)l * 3 * NMOD * D; (void)modl_;
                const float* xb_ = p_.xb();
                {
                    pg8::StaticOrder SO; SO.init(RL, D, G, (int)blockIdx.x);
                    pg8::Unit u;
                    for (int i = 0; SO.next(i, u); ++i) {
                        const int r0 = u.pm * 256 + u.pn * 64;
                        normmod_rows([&](int row) { return xb_ + (size_t)row * D; }, p_.sp_n2g() + l * D, modl_, 3, 4, p_.hb(), r0 + 64, r0 + wave, NWAVES, lane);
                    }
                    if (MR > RL) {
                        for (int piece = blockIdx.x; piece < 256; piece += G) {
                            const int pr = piece >> 4, pc = piece & 15;
                            const int r0 = RL + pr * 32 + pc * 2;
                            normmod_rows([&](int row) { return xb_ + (size_t)row * D; }, p_.sp_n2g() + l * D, modl_, 3, 4, p_.hb(), r0 + 2, r0 + wave, NWAVES, lane);
                        }
                    }
                }
                SYNC_AFTER(phase_id(l, PH_NORM2));
            }
            if (IN(phase_id(l, PH_G3))) {
                PHASE_COORDS const P p_ = fresh(p); const float* modl_ = p_.mod() + (size_t)l * 3 * NMOD * D; (void)modl_;
                pg8::Gemm g{p_.hb(), p_.wq_t() + (size_t)l * PH * QD * D, RL, PH * QD, D};
                pg8::StaticOrder S; S.init(RL, PH * QD, G, (int)blockIdx.x);
                pg8::EpiBf16<0> E{p_.qpb(), PH * QD, nullptr, 0, 0, 1.f};
                pg8::gemm_phase<pg8::EpiBf16<0>, pg8::StaticOrder, true, true>((PG8_LAS unsigned char*)lds, g, S, E);
                if (MR > RL) {
                    bf16_t* qo = p_.qpb() + (size_t)RL * (PH * QD);
                    ctx_gemm(p_.hb() + (size_t)RL * D, p_.wq_t() + (size_t)l * PH * QD * D, PH * QD, (LAS unsigned char*)lds,
                             [&](int row, int col, const pg8::f32x4& a) {
                                 v2u w; w.x = pg8::cvt_pk_bf16(a[0], a[1]); w.y = pg8::cvt_pk_bf16(a[2], a[3]);
                                 *(v2u*)(qo + (size_t)row * (PH * QD) + col) = w;
                             });
                }
                SYNC_AFTER(phase_id(l, PH_G3));
            }
            if (IN(phase_id(l, PH_PEER))) {
                PHASE_COORDS const P p_ = fresh(p); const float* modl_ = p_.mod() + (size_t)l * 3 * NMOD * D; (void)modl_;
                LAS unsigned char* L = (LAS unsigned char*)lds;
                LAS unsigned short* eid = (LAS unsigned short*)(L + 8192);
                LAS float* gwt = (LAS float*)(L + 16384);
                for (int tile = blockIdx.x; tile < RL / 32; tile += G) {
                    peer_score_tile(p_, l, tile * 32, MR, L, eid, gwt);
                    __syncthreads();
                    {
                        const int tid2 = opaque_tid(), lane2 = tid2 & 63, wave2 = __builtin_amdgcn_readfirstlane(tid2 >> 6);
                        LAS unsigned* sk = (LAS unsigned*)(L + 32768) + wave2 * 512;
                        LAS float* av = (LAS float*)(L + 49152) + wave2 * 512;
                        peer_apply_wave(p_, l, tile * 32 + wave2 * 4, eid + wave2 * 512, gwt + wave2 * 512, sk, av, lane2);
                    }
                    __syncthreads();
                }
                if (MR > RL) {
                    const int cpw = (R - RL + G - 1) / G, row0 = RL + blockIdx.x * cpw;
                    if (row0 < R) {
                        const int rend = row0 + cpw < R ? row0 + cpw : R;
                        peer_score_tile(p_, l, row0, rend, L, eid, gwt);
                        __syncthreads();
                        {
                            const int tid2 = opaque_tid(), lane2 = tid2 & 63, wave2 = __builtin_amdgcn_readfirstlane(tid2 >> 6);
                            LAS float* av = (LAS float*)(L + 49152) + wave2 * 512;
                            for (int t = wave2; row0 + t < rend; t += NWAVES) peer_apply_token64(p_, l, row0 + t, eid + t * 128, gwt + t * 128, av, lane2);
                        }
                        __syncthreads();
                    }
                }
                SYNC_AFTER(phase_id(l, PH_PEER));
            }
        }
    }
#undef IN
#undef SYNC_AFTER
#undef PHASE_COORDS
}

static void launch_mega(const P& p, int lo, int hi, int grid, hipStream_t stream) {
    P pp = p; int a = lo, b = hi;
    void* args[] = {(void*)&pp, (void*)&a, (void*)&b};
    hipError_t e = hipLaunchCooperativeKernel((const void*)mega, dim3(grid), dim3(NWAVES * 64), args, LDS_BYTES, stream);
    if (e != hipSuccess) fprintf(stderr, "cooperative launch failed: %s (grid %d)\n", hipGetErrorString(e), grid);
}

extern "C" void kernel_launch(void* const* d_in, const int* in_sizes, int n_in, void* d_out, int out_size, void* d_ws, size_t ws_size, hipStream_t stream) {
    static int grid = 0;
    if (grid == 0) {
        int dev = 0, cus = 0, per_cu = 0;
        (void)hipGetDevice(&dev);
        (void)hipDeviceGetAttribute(&cus, hipDeviceAttributeMultiprocessorCount, dev);
        (void)hipFuncSetAttribute((const void*)mega, hipFuncAttributeMaxDynamicSharedMemorySize, LDS_BYTES);
        (void)hipOccupancyMaxActiveBlocksPerMultiprocessor(&per_cu, (const void*)mega, NWAVES * 64, LDS_BYTES);
        if (per_cu < 1) { fprintf(stderr, "occupancy query says %d blocks/CU\n", per_cu); per_cu = 1; }
        grid = cus * per_cu;
        fprintf(stderr, "grid = %d (cus %d x %d), ws_size = %zu\n", grid, cus, per_cu, ws_size);
    }
    P p{};
    for (int i = 0; i < 31; ++i) p.in[i] = (const float*)d_in[i];
    p.out_ = (float*)d_out; p.ws = (unsigned char*)d_ws;
    if (WS_TOTAL > ws_size || n_in != 31) { fprintf(stderr, "workspace too small or bad inputs: need %zu have %zu, n_in %d\n", (size_t)WS_TOTAL, ws_size, n_in); return; }

    (void)hipMemsetAsync((char*)d_ws + OFF_ctl, 0, CTL_BYTES, stream);
    launch_mega(p, PH_PRO, phase_id(DEPTH - 1, PH_PEER) + 1, grid, stream);
}
```

```cpp
#include <hip/hip_runtime.h>
#include <cstdio>
#include <cstdint>
#include <cmath>
#include <hip/hip_cooperative_groups.h>
namespace cg = cooperative_groups;
typedef unsigned short bf16_t;

constexpr int D = 1024, BATCH = 2, SEQ = 8192, DEPTH = 2, CTX = 256, GRIDW = 64;
constexpr int RL = BATCH * SEQ;
constexpr int RC = BATCH * CTX;
constexpr int R = RL + RC;
constexpr int NMOD = 6;
constexpr int ATTN_W = 512, HD = 64, VD = 128, NH = 4;
constexpr int SSM_W = 256, SG = 16, NG = 16, PS = 64;
constexpr int POOL_W = 256;
constexpr int SSM_OFF = 1536, POOL_OFF = 1792, IN_W = 2048;
constexpr int PH = 8, NK = 128, QD = 256, KD = 128, TOPK = 16;
constexpr float EPS = 1e-6f;

constexpr size_t ws_al(size_t x) { return (x + 255) / 256 * 256; }
constexpr size_t OFF_ctl = 0;
constexpr size_t CTL_BYTES = 16384;
constexpr size_t OFF_mod = OFF_ctl + CTL_BYTES;
constexpr size_t OFF_sp_n1g = OFF_mod + ws_al((size_t)DEPTH*3*NMOD*D*4);
constexpr size_t OFF_sp_n2g = OFF_sp_n1g + ws_al((size_t)DEPTH*D*4);
constexpr size_t OFF_sp_fing = OFF_sp_n2g + ws_al((size_t)DEPTH*D*4);
constexpr size_t OFF_sp_lam = OFF_sp_fing + ws_al((size_t)D*4);
constexpr size_t OFF_sp_subln = OFF_sp_lam + ws_al(256);
constexpr size_t OFF_sp_ssmd = OFF_sp_subln + ws_al((size_t)DEPTH*VD*4);
constexpr size_t OFF_sp_poolsc = OFF_sp_ssmd + ws_al((size_t)DEPTH*SSM_W*4);
constexpr size_t OFF_sp_a64 = OFF_sp_poolsc + ws_al((size_t)DEPTH*POOL_W*4);
constexpr size_t OFF_ropet = OFF_sp_a64 + ws_al((size_t)64*64*2*4);
constexpr size_t OFF_w_in_t = OFF_ropet + ws_al((size_t)SEQ*32*2*4);
constexpr size_t OFF_w_out_t = OFF_w_in_t + ws_al((size_t)DEPTH*IN_W*D*2);
constexpr size_t OFF_wq_t = OFF_w_out_t + ws_al((size_t)DEPTH*D*D*2);
constexpr size_t OFF_wglu_t = OFF_wq_t + ws_al((size_t)DEPTH*PH*QD*D*2);
constexpr size_t OFF_poolw_t = OFF_wglu_t + ws_al((size_t)DEPTH*SSM_W*SSM_W*2);
constexpr size_t OFF_keysb = OFF_poolw_t + ws_al((size_t)DEPTH*4*64*64*2);
constexpr size_t OFF_ssm_km = OFF_keysb + ws_al((size_t)DEPTH*PH*2*NK*KD*2);
constexpr size_t OFF_ssm_we = OFF_ssm_km + ws_al((size_t)64*64*256*2);
constexpr size_t OFF_ssm_wc = OFF_ssm_we + ws_al((size_t)64*128*1024*2);
constexpr size_t OFF_u16 = OFF_ssm_wc + ws_al((size_t)64*1024*128*2);
constexpr size_t OFF_v16 = OFF_u16 + ws_al((size_t)DEPTH*NK*NK*D);
constexpr size_t OFF_xb = OFF_v16 + ws_al((size_t)DEPTH*NK*NK*D);
constexpr size_t OFF_qb = OFF_xb + ws_al((size_t)R*D*4);
constexpr size_t OFF_kb = OFF_qb + ws_al((size_t)R*512*2);
constexpr size_t OFF_vb = OFF_kb + ws_al((size_t)R*512*2);
constexpr size_t OFF_ub = OFF_vb + ws_al((size_t)R*512*2);
constexpr size_t OFF_pb = OFF_ub + ws_al((size_t)R*256*2);
constexpr size_t OFF_mixb = OFF_pb + ws_al((size_t)R*256*2);
constexpr size_t OFF_yc = OFF_mixb + ws_al((size_t)R*D*2);
constexpr size_t OFF_hb = OFF_yc + ws_al((size_t)2*R*SSM_W*4);
constexpr size_t OFF_qpb = OFF_mixb;
constexpr size_t WS_TOTAL = OFF_hb + ws_al((size_t)R*D*2);
static_assert(OFF_mod == OFF_ctl + CTL_BYTES, "mod follows the barrier words (one memset)");
static_assert(OFF_kb == OFF_qb + (size_t)R*512*2 && OFF_vb == OFF_qb + (size_t)2*R*512*2 && OFF_ub == OFF_qb + (size_t)3*R*512*2 && OFF_pb == OFF_ub + (size_t)R*256*2, "in-proj outputs must be contiguous (EpiInProj)");
static_assert(OFF_yc == OFF_mixb + (size_t)R*D*2 && (size_t)R*PH*QD*2 <= (size_t)R*D*2 + (size_t)2*R*SSM_W*4, "qpb overlays mixb|yc");
struct P {
    const float* in[31]; float* out_; unsigned char* ws;
    __host__ __device__ __forceinline__ float* out() const { return out_; }
    __host__ __device__ __forceinline__ unsigned* ctl() const { return (unsigned*)(ws + OFF_ctl); }
    __host__ __device__ __forceinline__ const float* x() const { return in[0]; }
    __host__ __device__ __forceinline__ const float* c() const { return in[1]; }
    __host__ __device__ __forceinline__ const float* ctx() const { return in[2]; }
    __host__ __device__ __forceinline__ const float* c_ctx() const { return in[3]; }
    __host__ __device__ __forceinline__ const float* w_mod() const { return in[4]; }
    __host__ __device__ __forceinline__ const float* b_mod() const { return in[5]; }
    __host__ __device__ __forceinline__ const float* norm1_g() const { return in[6]; }
    __host__ __device__ __forceinline__ const float* norm2_g() const { return in[7]; }
    __host__ __device__ __forceinline__ const float* w_in() const { return in[8]; }
    __host__ __device__ __forceinline__ const float* w_out() const { return in[9]; }
    __host__ __device__ __forceinline__ const float* lam_q1() const { return in[10]; }
    __host__ __device__ __forceinline__ const float* lam_k1() const { return in[11]; }
    __host__ __device__ __forceinline__ const float* lam_q2() const { return in[12]; }
    __host__ __device__ __forceinline__ const float* lam_k2() const { return in[13]; }
    __host__ __device__ __forceinline__ const float* subln_g() const { return in[14]; }
    __host__ __device__ __forceinline__ const float* lre() const { return in[15]; }
    __host__ __device__ __forceinline__ const float* lim() const { return in[16]; }
    __host__ __device__ __forceinline__ const float* lstep() const { return in[17]; }
    __host__ __device__ __forceinline__ const float* bre() const { return in[18]; }
    __host__ __device__ __forceinline__ const float* bim() const { return in[19]; }
    __host__ __device__ __forceinline__ const float* cre() const { return in[20]; }
    __host__ __device__ __forceinline__ const float* cim() const { return in[21]; }
    __host__ __device__ __forceinline__ const float* ssm_d() const { return in[22]; }
    __host__ __device__ __forceinline__ const float* w_glu() const { return in[23]; }
    __host__ __device__ __forceinline__ const float* pool_w() const { return in[24]; }
    __host__ __device__ __forceinline__ const float* pool_scale() const { return in[25]; }
    __host__ __device__ __forceinline__ const float* wq() const { return in[26]; }
    __host__ __device__ __forceinline__ const float* keys() const { return in[27]; }
    __host__ __device__ __forceinline__ const float* pu() const { return in[28]; }
    __host__ __device__ __forceinline__ const float* pv() const { return in[29]; }
    __host__ __device__ __forceinline__ const float* final_g() const { return in[30]; }
    __host__ __device__ __forceinline__ float* mod() const { return (float*)(ws + OFF_mod); }
    __host__ __device__ __forceinline__ float* sp_n1g() const { return (float*)(ws + OFF_sp_n1g); }
    __host__ __device__ __forceinline__ float* sp_n2g() const { return (float*)(ws + OFF_sp_n2g); }
    __host__ __device__ __forceinline__ float* sp_fing() const { return (float*)(ws + OFF_sp_fing); }
    __host__ __device__ __forceinline__ float* sp_lam() const { return (float*)(ws + OFF_sp_lam); }
    __host__ __device__ __forceinline__ float* sp_subln() const { return (float*)(ws + OFF_sp_subln); }
    __host__ __device__ __forceinline__ float* sp_ssmd() const { return (float*)(ws + OFF_sp_ssmd); }
    __host__ __device__ __forceinline__ float* sp_poolsc() const { return (float*)(ws + OFF_sp_poolsc); }
    __host__ __device__ __forceinline__ float* sp_a64() const { return (float*)(ws + OFF_sp_a64); }
    __host__ __device__ __forceinline__ float* ropet() const { return (float*)(ws + OFF_ropet); }
    __host__ __device__ __forceinline__ bf16_t* w_in_t() const { return (bf16_t*)(ws + OFF_w_in_t); }
    __host__ __device__ __forceinline__ bf16_t* w_out_t() const { return (bf16_t*)(ws + OFF_w_out_t); }
    __host__ __device__ __forceinline__ bf16_t* wq_t() const { return (bf16_t*)(ws + OFF_wq_t); }
    __host__ __device__ __forceinline__ bf16_t* wglu_t() const { return (bf16_t*)(ws + OFF_wglu_t); }
    __host__ __device__ __forceinline__ bf16_t* poolw_t() const { return (bf16_t*)(ws + OFF_poolw_t); }
    __host__ __device__ __forceinline__ bf16_t* keysb() const { return (bf16_t*)(ws + OFF_keysb); }
    __host__ __device__ __forceinline__ bf16_t* ssm_km() const { return (bf16_t*)(ws + OFF_ssm_km); }
    __host__ __device__ __forceinline__ bf16_t* ssm_we() const { return (bf16_t*)(ws + OFF_ssm_we); }
    __host__ __device__ __forceinline__ bf16_t* ssm_wc() const { return (bf16_t*)(ws + OFF_ssm_wc); }
    __host__ __device__ __forceinline__ unsigned char* u8() const { return (unsigned char*)(ws + OFF_u16); }
    __host__ __device__ __forceinline__ unsigned char* v8() const { return (unsigned char*)(ws + OFF_v16); }
    __host__ __device__ __forceinline__ float* xb() const { return (float*)(ws + OFF_xb); }
    __host__ __device__ __forceinline__ bf16_t* qb() const { return (bf16_t*)(ws + OFF_qb); }
    __host__ __device__ __forceinline__ bf16_t* kb() const { return (bf16_t*)(ws + OFF_kb); }
    __host__ __device__ __forceinline__ bf16_t* vb() const { return (bf16_t*)(ws + OFF_vb); }
    __host__ __device__ __forceinline__ bf16_t* ub() const { return (bf16_t*)(ws + OFF_ub); }
    __host__ __device__ __forceinline__ bf16_t* pb() const { return (bf16_t*)(ws + OFF_pb); }
    __host__ __device__ __forceinline__ bf16_t* mixb() const { return (bf16_t*)(ws + OFF_mixb); }
    __host__ __device__ __forceinline__ float* yc() const { return (float*)(ws + OFF_yc); }
    __host__ __device__ __forceinline__ bf16_t* hb() const { return (bf16_t*)(ws + OFF_hb); }
    __host__ __device__ __forceinline__ bf16_t* qpb() const { return (bf16_t*)(ws + OFF_qpb); }
};

__device__ __forceinline__ int modset(int row) { return row < RL ? row / SEQ : 2; }
__device__ __forceinline__ float gelu_exact(float v) { return 0.5f * v * (1.0f + erff(v * 0.70710678118654752f)); }
__device__ __forceinline__ float wave_sum(float v) {
#pragma unroll
    for (int o = 32; o > 0; o >>= 1) v += __shfl_xor(v, o);
    return v;
}

__device__ __forceinline__ int opaque_tid() { int t = threadIdx.x; asm volatile("" : "+v"(t)); return t; }

namespace pg8 {
#define PG8_LAS __attribute__((address_space(3)))
typedef unsigned short bf16_t;
typedef short bf16x8 __attribute__((ext_vector_type(8)));
typedef float f32x4 __attribute__((ext_vector_type(4)));
typedef unsigned u32x4 __attribute__((ext_vector_type(4)));
constexpr int BM = 256, BK = 64, HALF = 128, HTB = HALF * BK * 2  , STAGE_BYTES = 8 * HTB, NXCD = 8, WGM = 8;

__host__ __device__ __forceinline__ int lds_byte(int r, int c) { const int st = (r >> 4) * 2 + (c >> 5), rr = r & 15, cc = c & 31, ob = rr * 64 + cc * 2; return st * 1024 + (ob ^ (((ob >> 9) & 1) << 5)); }
__host__ __device__ __forceinline__ void stage_rc(int b, int& R, int& C) { const int st = b / 1024, sb = b % 1024, swz = sb ^ (((sb >> 9) & 1) << 5); R = (st >> 1) * 16 + swz / 64; C = (st & 1) * 32 + (swz % 64) / 2; }
__host__ __device__ __forceinline__ int perm32(int rho) { const int n = rho >> 4, i = rho & 15; return 8 * (i >> 2) + 4 * n + (i & 3); }

struct Unit { int pm, pn; };
struct Gemm { const bf16_t* A; const bf16_t* Bt; int M, N, K; };

struct StaticOrder {
    int nM, nN, nwg, G, c;
    __host__ __device__ void init(int M, int N, int G_, int c_) { nM = M / BM; nN = N / BM; nwg = nM * nN; G = G_; c = c_; }
    __host__ __device__ bool next(int i, Unit& u) const {
        const long L = (long)i * G + c; if (L >= nwg) return false;
        int wgid = (int)L; { const int q = nwg / NXCD, r = nwg % NXCD, xcd = wgid % NXCD, off = wgid / NXCD; wgid = (xcd < r ? xcd * (q + 1) : r * (q + 1) + (xcd - r) * q) + off; }
        const int nig = WGM * nN, gid = wgid / nig, fm = gid * WGM, gsz = (nM - fm) < WGM ? (nM - fm) : WGM;
        u.pm = fm + ((wgid % nig) % gsz); u.pn = (wgid % nig) / gsz; return true;
    }
    __device__ __forceinline__ void a_ready(const Unit&) const {}
    __device__ __forceinline__ void done(const Unit&) const {}
};

struct InProjOrder {
    int G, c; unsigned* cnt;
    __host__ __device__ static int n_ssm_wg(int G) { return G >= 128 ? 64 : 0; }
    __host__ __device__ bool next(int i, Unit& u) const {
        if (G == 256) {
            const int x = c & 7, s = c >> 3, npm = 8 + (x < 2 ? 1 : 0);
            int idx;
            if (i == 0) idx = s; else if (s >= 24) return false; else if (i == 1) idx = 32 + s; else if (i == 2) idx = 56 + s; else return false;
            if (idx >= npm * 8) return false;
            if (idx < npm) { u.pm = idx < 8 ? x * 8 + idx : 64 + x; u.pn = 6; }
            else { const int k = idx - npm, j = k / 7, q = k - j * 7; u.pm = j < 8 ? x * 8 + j : 64 + x; u.pn = q < 6 ? q : 7; }
            return true;
        }
        const int nw = G - n_ssm_wg(G);
        int idx;
        if (i == 0) idx = c; else if (c >= nw) return false; else idx = G + (i - 1) * nw + c;
        if (idx >= 66 * 8) return false;
        if (idx < 66) { u.pm = idx; u.pn = 6; } else { const int k = idx - 66, j = k / 7, q = k - j * 7; u.pm = j; u.pn = q < 6 ? q : 7; }
        return true;
    }
    __device__ __forceinline__ void a_ready(const Unit&) const {}
    __device__ __forceinline__ void done(const Unit& u) const {
        if (u.pn == 6) {
            asm volatile("s_waitcnt vmcnt(0)" ::: "memory");
            if ((threadIdx.x & 63) == 0) (void)__hip_atomic_fetch_add(cnt, 1u, __ATOMIC_RELAXED, __HIP_MEMORY_SCOPE_AGENT);
        }
    }
};

__device__ __forceinline__ unsigned cvt_pk_bf16(float lo, float hi) { unsigned r; asm volatile("v_cvt_pk_bf16_f32 %0, %1, %2" : "=v"(r) : "v"(lo), "v"(hi)); return r; }
typedef float f32x2 __attribute__((ext_vector_type(2)));
__device__ __forceinline__ f32x2 gelu_pk(f32x2 v) {
    const f32x2 av = __builtin_elementwise_abs(v), d = av * 0.2316418882f + 1.0f;
    f32x2 t; t.x = __builtin_amdgcn_rcpf(d.x); t.y = __builtin_amdgcn_rcpf(d.y);
    f32x2 q = t * 0.5307027145f + (-0.7265760135f); q = q * t + 0.7107068705f; q = q * t + (-0.142248368f); q = q * t + 0.127414796f; q = q * t;
    const f32x2 s = (v * v) * (-0.72134752044f);
    f32x2 e; e.x = __builtin_amdgcn_exp2f(s.x); e.y = __builtin_amdgcn_exp2f(s.y);
    const f32x2 m = v * (q * e), r = v - m;
    f32x2 o; o.x = v.x < 0.f ? m.x : r.x; o.y = v.y < 0.f ? m.y : r.y; return o;
}

template <int ACT  > struct EpiBf16 {
    static constexpr bool PERM = true, AFTER_DRAIN = false; static_assert(ACT == 0 || ACT == 1, "EpiBf16: ACT is 0 (none) or 1 (gelu_pk)");
    bf16_t* O; int ldc; const float* bias; int split_cols; size_t split_stride; float scale0;
    __device__ __forceinline__ void operator()(const f32x4 (&acc)[2][2][4][2], const Unit& u, int wr, int wc, int fr, int fq) const {
        const int row0 = u.pm * BM + wr * 64 + fr; int colt = u.pn * BM; bf16_t* base = O;
        float sc = 1.f; if (split_cols) { const int t = colt / split_cols; base += (size_t)t * split_stride; colt -= t * split_cols; if (t == 0) sc = scale0; }
        const int col0 = colt + wc * 32 + 8 * fq, bcol0 = u.pn * BM + wc * 32 + 8 * fq;
        f32x4 bv[2][2];
#pragma unroll
        for (int bj = 0; bj < 2; ++bj)
#pragma unroll
            for (int n = 0; n < 2; ++n) bv[bj][n] = bias ? *(const f32x4*)(bias + bcol0 + bj * HALF + 4 * n) : (f32x4){0.f, 0.f, 0.f, 0.f};
#pragma unroll
        for (int ai = 0; ai < 2; ++ai)
#pragma unroll
            for (int m = 0; m < 4; ++m) { bf16_t* rowp = base + (size_t)(row0 + ai * HALF + m * 16) * ldc + col0;
#pragma unroll
                for (int bj = 0; bj < 2; ++bj) { f32x4 v0 = acc[ai][bj][m][0] + bv[bj][0], v1 = acc[ai][bj][m][1] + bv[bj][1];
                    if (ACT == 1) { f32x2 a = gelu_pk((f32x2){v0[0], v0[1]}), b = gelu_pk((f32x2){v0[2], v0[3]}), c = gelu_pk((f32x2){v1[0], v1[1]}), d = gelu_pk((f32x2){v1[2], v1[3]});
                        v0 = (f32x4){a.x, a.y, b.x, b.y}; v1 = (f32x4){c.x, c.y, d.x, d.y}; }
                    v0 = v0 * sc; v1 = v1 * sc; u32x4 w; w.x = cvt_pk_bf16(v0[0], v0[1]); w.y = cvt_pk_bf16(v0[2], v0[3]); w.z = cvt_pk_bf16(v1[0], v1[1]); w.w = cvt_pk_bf16(v1[2], v1[3]);
                    *(u32x4*)(rowp + bj * HALF) = w; } }
    }
};
template <class Epi, class Sched, bool ALIGN_EPI = false, bool SP2 = false>
__device__ __forceinline__ void gemm_phase(PG8_LAS unsigned char* lds, const Gemm g, const Sched& S, const Epi& E) {
    const int tid = opaque_tid(), wid = __builtin_amdgcn_readfirstlane(tid >> 6), lane = tid & 63, wr = wid >> 2, wc = wid & 3, fr = lane & 15, fq = lane >> 4;
    const int K = g.K, nt = K / BK;
    unsigned voffA[2], voffB[2];
#pragma unroll
    for (int i = 0; i < 2; ++i) { int R, C; stage_rc(tid * 16 + i * 8192, R, C); const int Rb = Epi::PERM ? ((R & ~31) + perm32(R & 31)) : R;
        voffA[i] = (unsigned)(R * K + C) * 2u; voffB[i] = (unsigned)(Rb * K + C) * 2u; }
    const size_t kstep = (size_t)(BK * 2);
    const size_t hstep = (size_t)HALF * K * 2;
    const size_t tstep = 2 * hstep;
    const unsigned ldsw = (unsigned)wid * 1024u;
    const int aoff = lds_byte(wr * 64 + fr, fq * 8), boff = lds_byte(wc * 32 + fr, fq * 8);
#define PG8_SA(b, h) (((b) * 2 + (h)) * HTB)
#define PG8_SB(b, h) ((4 + (b) * 2 + (h)) * HTB)
#define PG8_STAGE(bufoff, gbase, voff) do { _Pragma("unroll") for (int _i = 0; _i < 2; ++_i) \
        __builtin_amdgcn_global_load_lds((const unsigned*)((const char*)(gbase) + (voff)[_i]), (PG8_LAS unsigned*)(lds + (bufoff) + ldsw + _i * 8192), 16, 0, 0); } while (0)
#define PG8_LDA(dst, b, h) do { _Pragma("unroll") for (int m = 0; m < 4; ++m) _Pragma("unroll") for (int k = 0; k < 2; ++k) dst[m][k] = *(const PG8_LAS bf16x8*)(lds + PG8_SA(b, h) + aoff + m * 2048 + k * 1024); } while (0)
#define PG8_LDB(dst, b, h) do { _Pragma("unroll") for (int n = 0; n < 2; ++n) _Pragma("unroll") for (int k = 0; k < 2; ++k) dst[n][k] = *(const PG8_LAS bf16x8*)(lds + PG8_SB(b, h) + boff + n * 2048 + k * 1024); } while (0)
#define PG8_MMA(ai, bj, At, Bt) do { __builtin_amdgcn_s_setprio(1); _Pragma("unroll") for (int m = 0; m < 4; ++m) _Pragma("unroll") for (int n = 0; n < 2; ++n) _Pragma("unroll") for (int k = 0; k < 2; ++k) \
        acc[ai][bj][m][n] = __builtin_amdgcn_mfma_f32_16x16x32_bf16(Bt[n][k], At[m][k], acc[ai][bj][m][n], 0, 0, 0); __builtin_amdgcn_s_setprio(0); } while (0)
#define PG8_WAIT_V(n) asm volatile("s_waitcnt vmcnt(" #n ")" ::: "memory")
#define PG8_WAIT_L(n) asm volatile("s_waitcnt lgkmcnt(" #n ")" ::: "memory")
#define PG8_BAR __builtin_amdgcn_s_barrier()
#define PG8_SCHED __builtin_amdgcn_sched_barrier(0)
    Unit cur, nxt; int ui = 0;
    if (!S.next(0, cur)) return;
    f32x4 acc[2][2][4][2];
#pragma unroll
    for (int a = 0; a < 2; ++a)
#pragma unroll
        for (int b = 0; b < 2; ++b)
#pragma unroll
            for (int m = 0; m < 4; ++m)
#pragma unroll
                for (int n = 0; n < 2; ++n) acc[a][b][m][n] = (f32x4){0.f, 0.f, 0.f, 0.f};
    bf16x8 At[4][2], B0[2][2], B1[2][2];
    const char* cA = (const char*)g.A + (size_t)cur.pm * tstep; const char* cB = (const char*)g.Bt + (size_t)cur.pn * tstep;
    S.a_ready(cur);
    if constexpr (SP2) {
        PG8_STAGE(PG8_SB(0, 0), cB, voffB); PG8_STAGE(PG8_SB(0, 1), cB + hstep, voffB); PG8_STAGE(PG8_SA(0, 0), cA, voffA); PG8_STAGE(PG8_SA(0, 1), cA + hstep, voffA);
        if (wr == 1) PG8_BAR;
        PG8_WAIT_V(2); PG8_BAR;
        PG8_STAGE(PG8_SB(1, 0), cB + kstep, voffB); PG8_STAGE(PG8_SA(1, 0), cA + kstep, voffA); PG8_STAGE(PG8_SB(1, 1), cB + hstep + kstep, voffB);
        PG8_WAIT_V(6); PG8_BAR;
    } else {
        PG8_STAGE(PG8_SB(0, 0), cB, voffB); PG8_STAGE(PG8_SA(0, 0), cA, voffA); PG8_STAGE(PG8_SB(0, 1), cB + hstep, voffB); PG8_STAGE(PG8_SA(0, 1), cA + hstep, voffA);
        if (wr == 1) PG8_BAR;
        PG8_WAIT_V(4); PG8_BAR;
        PG8_STAGE(PG8_SB(1, 0), cB + kstep, voffB); PG8_STAGE(PG8_SA(1, 0), cA + kstep, voffA); PG8_STAGE(PG8_SB(1, 1), cB + hstep + kstep, voffB);
        PG8_WAIT_V(6); PG8_BAR;
    }
    for (;;) {
        const bool has_next = S.next(ui + 1, nxt);
        const char* nA = has_next ? (const char*)g.A + (size_t)nxt.pm * tstep : cA; const char* nB = has_next ? (const char*)g.Bt + (size_t)nxt.pn * tstep : cB;
        for (int t = 0; t < nt; t += 2) {
            const bool last = (t == nt - 2);
            const char* a1 = cA + (size_t)(t + 1) * kstep;
            const char* a2 = last ? nA : cA + (size_t)(t + 2) * kstep; const char* b2 = last ? nB : cB + (size_t)(t + 2) * kstep;
            const char* a3 = a2 + kstep; const char* b3 = b2 + kstep;
            if (last && has_next) S.a_ready(nxt);
            if constexpr (SP2) {
            PG8_LDB(B0, 0, 0); PG8_LDB(B1, 0, 1); PG8_SCHED; PG8_LDA(At, 0, 0); PG8_STAGE(PG8_SA(1, 1), a1 + hstep, voffA);
            PG8_WAIT_V(8); PG8_WAIT_L(0); PG8_BAR; PG8_MMA(0, 0, At, B0); PG8_MMA(0, 1, At, B1); PG8_BAR; PG8_SCHED;
            PG8_LDA(At, 0, 1); PG8_STAGE(PG8_SB(0, 0), b2, voffB); PG8_STAGE(PG8_SB(0, 1), b2 + hstep, voffB); PG8_STAGE(PG8_SA(0, 0), a2, voffA);
            PG8_WAIT_V(8); PG8_WAIT_L(0); PG8_BAR; PG8_MMA(1, 0, At, B0); PG8_MMA(1, 1, At, B1); PG8_BAR; PG8_SCHED;
            PG8_LDB(B0, 1, 0); PG8_LDB(B1, 1, 1); PG8_SCHED; PG8_LDA(At, 1, 0); PG8_STAGE(PG8_SA(0, 1), a2 + hstep, voffA);
            PG8_WAIT_V(8); PG8_WAIT_L(0); PG8_BAR; PG8_MMA(0, 0, At, B0); PG8_MMA(0, 1, At, B1); PG8_BAR; PG8_SCHED;
            PG8_LDA(At, 1, 1); PG8_STAGE(PG8_SB(1, 0), b3, voffB); PG8_STAGE(PG8_SB(1, 1), b3 + hstep, voffB); PG8_STAGE(PG8_SA(1, 0), a3, voffA);
            PG8_WAIT_V(8); PG8_WAIT_L(0); PG8_BAR; PG8_MMA(1, 0, At, B0); PG8_MMA(1, 1, At, B1); PG8_BAR; PG8_SCHED;
            } else {
            PG8_LDB(B0, 0, 0); PG8_SCHED; PG8_LDA(At, 0, 0); PG8_STAGE(PG8_SA(1, 1), a1 + hstep, voffA);
            PG8_WAIT_L(8); PG8_BAR; PG8_WAIT_L(0); PG8_MMA(0, 0, At, B0); PG8_BAR; PG8_SCHED;
            PG8_LDB(B1, 0, 1); PG8_STAGE(PG8_SB(0, 0), b2, voffB);
            PG8_BAR; PG8_WAIT_L(0); PG8_MMA(0, 1, At, B1); PG8_BAR;
            PG8_LDA(At, 0, 1); PG8_STAGE(PG8_SA(0, 0), a2, voffA);
            PG8_BAR; PG8_WAIT_L(0); PG8_MMA(1, 0, At, B0); PG8_BAR; PG8_SCHED;
            PG8_STAGE(PG8_SB(0, 1), b2 + hstep, voffB);
            PG8_WAIT_V(6); PG8_BAR; PG8_MMA(1, 1, At, B1); PG8_BAR;
            PG8_LDB(B0, 1, 0); PG8_SCHED; PG8_LDA(At, 1, 0); PG8_STAGE(PG8_SA(0, 1), a2 + hstep, voffA);
            PG8_WAIT_L(8); PG8_BAR; PG8_WAIT_L(0); PG8_MMA(0, 0, At, B0); PG8_BAR; PG8_SCHED;
            PG8_LDB(B1, 1, 1); PG8_STAGE(PG8_SB(1, 0), b3, voffB);
            PG8_BAR; PG8_WAIT_L(0); PG8_MMA(0, 1, At, B1); PG8_BAR;
            PG8_LDA(At, 1, 1); PG8_STAGE(PG8_SA(1, 0), a3, voffA);
            PG8_BAR; PG8_WAIT_L(0); PG8_MMA(1, 0, At, B0); PG8_BAR; PG8_SCHED;
            PG8_STAGE(PG8_SB(1, 1), b3 + hstep, voffB);
            PG8_WAIT_V(6); PG8_BAR; PG8_MMA(1, 1, At, B1); PG8_BAR;
            }
        }
        if constexpr (ALIGN_EPI) { if (wr == 0) PG8_BAR; }
        if constexpr (!Epi::AFTER_DRAIN) { E(acc, cur, wr, wc, fr, fq); S.done(cur); }
        if (!has_next) break;
#pragma unroll
        for (int a = 0; a < 2; ++a)
#pragma unroll
            for (int b = 0; b < 2; ++b)
#pragma unroll
                for (int m = 0; m < 4; ++m)
#pragma unroll
                    for (int n = 0; n < 2; ++n) acc[a][b][m][n] = (f32x4){0.f, 0.f, 0.f, 0.f};
        cur = nxt; cA = nA; cB = nB; ++ui;
        if constexpr (ALIGN_EPI) { if (wr == 1) PG8_BAR; }
    }
    PG8_WAIT_V(0);
    if constexpr (!ALIGN_EPI) { if (wr == 0) PG8_BAR; }
    PG8_BAR;
    if constexpr (Epi::AFTER_DRAIN) { E.fused(acc, cur, wr, wc, fr, fq, lds, wid, lane); S.done(cur); }
#undef PG8_SA
#undef PG8_SB
#undef PG8_STAGE
#undef PG8_LDA
#undef PG8_LDB
#undef PG8_MMA
#undef PG8_WAIT_V
#undef PG8_WAIT_L
#undef PG8_BAR
#undef PG8_SCHED
}
}

constexpr int LDS_BYTES = 147456;
constexpr int NWAVES = 8;
constexpr float LOG2E = 1.4426950408889634f;
constexpr float QSCALE = 0.125f * LOG2E;
constexpr float U8_SCALE = 64.0f, V8_SCALE = 8.0f;
#define LAS __attribute__((address_space(3)))
typedef unsigned v4u __attribute__((ext_vector_type(4)));
typedef unsigned v2u __attribute__((ext_vector_type(2)));
typedef float f32x4 __attribute__((ext_vector_type(4)));

__device__ __forceinline__ unsigned pkbf(float lo, float hi) { unsigned r; asm("v_cvt_pk_bf16_f32 %0, %1, %2" : "=v"(r) : "v"(lo), "v"(hi)); return r; }
__device__ __forceinline__ float bf2f(unsigned short b) { return __uint_as_float((unsigned)b << 16); }

struct EpiInProj {
    static constexpr bool PERM = false, AFTER_DRAIN = false;
    bf16_t* base; const float* ropet;
    __device__ __forceinline__ void operator()(const pg8::f32x4 (&acc)[2][2][4][2], const pg8::Unit& u, int wr, int wc, int fr, int fq) const {
        const int pn = u.pn;
#pragma unroll
        for (int ai = 0; ai < 2; ++ai)
#pragma unroll
            for (int m = 0; m < 4; ++m) {
                const int row = u.pm * 256 + ai * 128 + wr * 64 + m * 16 + fr;
                if (pn < 4) {
                    bf16_t* dst = base + (size_t)(pn >> 1) * ((size_t)R * 512) + (size_t)row * 512 + (pn & 1) * 256 + wc * 32 + fq * 4;
                    f32x4 cs0 = {1.f, 0.f, 1.f, 0.f}, cs1 = {1.f, 0.f, 1.f, 0.f};
                    if (row < RL) {
                        const int t = row & (SEQ - 1);
                        const float* tp = ropet + ((size_t)(t * 2 + (wc & 1)) * 16 + fq * 4) * 2;
                        cs0 = *(const f32x4*)tp; cs1 = *(const f32x4*)(tp + 4);
                    }
                    const float sc = pn < 2 ? QSCALE : 1.0f;
#pragma unroll
                    for (int bj = 0; bj < 2; ++bj) {
                        const pg8::f32x4 x1 = acc[ai][bj][m][0], x2 = acc[ai][bj][m][1];
                        float o1[4], o2[4];
                        const float c[4] = {cs0[0], cs0[2], cs1[0], cs1[2]}, s[4] = {cs0[1], cs0[3], cs1[1], cs1[3]};
#pragma unroll
                        for (int j = 0; j < 4; ++j) { o1[j] = (x1[j] * c[j] - x2[j] * s[j]) * sc; o2[j] = (x2[j] * c[j] + x1[j] * s[j]) * sc; }
                        v2u w1, w2; w1.x = pkbf(o1[0], o1[1]); w1.y = pkbf(o1[2], o1[3]); w2.x = pkbf(o2[0], o2[1]); w2.y = pkbf(o2[2], o2[3]);
                        *(v2u*)(dst + bj * 128) = w1; *(v2u*)(dst + bj * 128 + 16) = w2;
                    }
                } else {
                    if (pn == 6) {
#pragma unroll
                        for (int bj = 0; bj < 2; ++bj)
#pragma unroll
                            for (int n = 0; n < 2; ++n) { const pg8::f32x4 x = acc[ai][bj][m][n]; v2u w; w.x = pkbf(x[0], x[1]); w.y = pkbf(x[2], x[3]);
                                __hip_atomic_store((unsigned long long*)(base + (size_t)3 * R * 512 + ((size_t)(bj * 8 + wc * 2 + n) * R + row) * 16 + fq * 4), ((unsigned long long)w.y << 32) | w.x, __ATOMIC_RELAXED, __HIP_MEMORY_SCOPE_AGENT); }
                    } else {
                    const int ld = pn < 6 ? 512 : 256, c0 = pn == 5 ? 256 : 0;
                    const size_t boff = pn < 6 ? (size_t)2 * R * 512 : (size_t)3 * R * 512 + (size_t)R * 256;
                    bf16_t* dst = base + boff + (size_t)row * ld + c0 + wc * 32 + fq * 4;
#pragma unroll
                    for (int bj = 0; bj < 2; ++bj)
#pragma unroll
                        for (int n = 0; n < 2; ++n) { const pg8::f32x4 x = acc[ai][bj][m][n]; v2u w; w.x = pkbf(x[0], x[1]); w.y = pkbf(x[2], x[3]); *(v2u*)(dst + bj * 128 + n * 16) = w; }
                    }
                }
            }
    }
};

struct EpiResid {
    static constexpr bool PERM = true, AFTER_DRAIN = false;
    float* xb; const float* modl; const float* xin; const float* cin;
    __device__ __forceinline__ void operator()(const pg8::f32x4 (&acc)[2][2][4][2], const pg8::Unit& u, int wr, int wc, int fr, int fq) const {
#pragma unroll
        for (int ai = 0; ai < 2; ++ai)
#pragma unroll
            for (int m = 0; m < 4; ++m) {
                const int row = u.pm * 256 + ai * 128 + wr * 64 + m * 16 + fr, col0 = u.pn * 256 + wc * 32 + fq * 8;
                const float* mm = modl + (size_t)modset(row) * (NMOD * D) + 2 * D + col0;
                float* xr = xb + (size_t)row * D + col0;
                const float* xs = (row < RL ? xin + (size_t)row * D : cin + (size_t)(row - RL) * D) + col0;
#pragma unroll
                for (int bj = 0; bj < 2; ++bj)
#pragma unroll
                    for (int n = 0; n < 2; ++n) {
                        const pg8::f32x4 g = *(const pg8::f32x4*)(mm + bj * 128 + n * 4);
                        pg8::f32x4 xv = *(const pg8::f32x4*)(xs + bj * 128 + n * 4);
                        xv = xv + g * acc[ai][bj][m][n];
                        *(pg8::f32x4*)(xr + bj * 128 + n * 4) = xv;
                    }
            }
    }
};

__device__ __forceinline__ void transpose_item(const float* W, int K, int N, bf16_t* WT, LAS float* scr, int item, int lane) {
    const int nblk = N / 32, kb = item / nblk, nb = item % nblk, k0 = 64 * kb, n0 = 32 * nb;
#pragma unroll 8
    for (int i = 0; i < 32; ++i) { const int kk = 2 * i + (lane >> 5); scr[kk * 33 + (lane & 31)] = W[(size_t)(k0 + kk) * N + n0 + (lane & 31)]; }
    asm volatile("s_waitcnt lgkmcnt(0)" ::: "memory");
    const int c = lane & 7;
#pragma unroll
    for (int j = 0; j < 4; ++j) { const int n = (lane >> 3) + 8 * j; const LAS float* s = scr + (8 * c) * 33 + n;
        v4u o; o.x = pkbf(s[0 * 33], s[1 * 33]); o.y = pkbf(s[2 * 33], s[3 * 33]); o.z = pkbf(s[4 * 33], s[5 * 33]); o.w = pkbf(s[6 * 33], s[7 * 33]);
        *(v4u*)(WT + (size_t)(n0 + n) * K + k0 + 8 * c) = o; }
    asm volatile("s_waitcnt lgkmcnt(0)" ::: "memory");
}

__device__ __forceinline__ void normmod_row_bf16(const float* xrow, const float* g, const float* shift, const float* scale, bf16_t* orow, int lane) {
    f32x4 v[4]; float ss = 0.f;
#pragma unroll
    for (int j = 0; j < 4; ++j) { v[j] = ((const f32x4*)xrow)[lane + 64 * j]; ss += (v[j][0] * v[j][0] + v[j][1] * v[j][1]) + (v[j][2] * v[j][2] + v[j][3] * v[j][3]); }
    ss = wave_sum(ss);
    const float r = rsqrtf(ss * (1.0f / D) + EPS);
#pragma unroll
    for (int j = 0; j < 4; ++j) {
        const f32x4 gg = ((const f32x4*)g)[lane + 64 * j], sh = ((const f32x4*)shift)[lane + 64 * j], sc = ((const f32x4*)scale)[lane + 64 * j];
        float o[4];
#pragma unroll
        for (int e = 0; e < 4; ++e) o[e] = v[j][e] * r * gg[e] * (1.0f + sc[e]) + sh[e];
        v2u w; w.x = pkbf(o[0], o[1]); w.y = pkbf(o[2], o[3]);
        ((v2u*)orow)[lane + 64 * j] = w;
    }
}

template <class SrcF>
__device__ __forceinline__ void normmod_rows(const SrcF& src, const float* g, const float* modl, int shift_vec, int scale_vec, bf16_t* hb, int MR, int gw, int NGW, int lane) {
    if (gw >= MR) return;
    f32x4 ca[4], cb[4], vn[4];
    int cur = -1;
    {
        const float* x0 = src(gw);
#pragma unroll
        for (int j = 0; j < 4; ++j) vn[j] = ((const f32x4*)x0)[lane + 64 * j];
    }
    for (int row = gw; row < MR; row += NGW) {
        f32x4 v[4];
#pragma unroll
        for (int j = 0; j < 4; ++j) v[j] = vn[j];
        if (row + NGW < MR) {
            const float* xn = src(row + NGW);
#pragma unroll
            for (int j = 0; j < 4; ++j) vn[j] = ((const f32x4*)xn)[lane + 64 * j];
        }
        const int ms = modset(row);
        if (ms != cur) {
            cur = ms;
            const float* m = modl + (size_t)ms * (NMOD * D);
#pragma unroll
            for (int j = 0; j < 4; ++j) {
                const f32x4 gg = ((const f32x4*)g)[lane + 64 * j], sh = ((const f32x4*)(m + shift_vec * D))[lane + 64 * j], sc = ((const f32x4*)(m + scale_vec * D))[lane + 64 * j];
#pragma unroll
                for (int e = 0; e < 4; ++e) { ca[j][e] = gg[e] * (1.0f + sc[e]); cb[j][e] = sh[e]; }
            }
        }
        float ss = 0.f;
#pragma unroll
        for (int j = 0; j < 4; ++j) ss += (v[j][0] * v[j][0] + v[j][1] * v[j][1]) + (v[j][2] * v[j][2] + v[j][3] * v[j][3]);
        ss = wave_sum(ss);
        const float r = rsqrtf(ss * (1.0f / D) + EPS);
        bf16_t* orow = hb + (size_t)row * D;
#pragma unroll
        for (int j = 0; j < 4; ++j) {
            v2u w; w.x = pkbf(v[j][0] * r * ca[j][0] + cb[j][0], v[j][1] * r * ca[j][1] + cb[j][1]); w.y = pkbf(v[j][2] * r * ca[j][2] + cb[j][2], v[j][3] * r * ca[j][3] + cb[j][3]);
            ((v2u*)orow)[lane + 64 * j] = w;
        }
    }
}

typedef short bf16x8 __attribute__((ext_vector_type(8)));
typedef short s16x4 __attribute__((ext_vector_type(4)));
typedef float f32x16 __attribute__((ext_vector_type(16)));
constexpr int AT_STAGE = 32768;
constexpr int AT_QB = 128;

__device__ __forceinline__ float swap32(float v) {
    auto rr = __builtin_amdgcn_permlane32_swap(__float_as_uint(v), __float_as_uint(v), false, false);
    return (threadIdx.x & 32) ? __uint_as_float(rr[0]) : __uint_as_float(rr[1]);
}
__device__ __forceinline__ s16x4 vtr(const LAS unsigned char* p) {
    typedef short v4i16_t __attribute__((ext_vector_type(4)));
    return __builtin_bit_cast(s16x4, __builtin_amdgcn_ds_read_tr16_b64_v4i16((LAS v4i16_t*)p));
}

struct AttnUnit { int qrow0, hs0, kb0, n0, kb1, n1; };

__device__ __forceinline__ void attn_dma_k(const P& p, LAS unsigned char* slot, int krow0, int h4, int wave, int lane) {
    const int key = wave * 8 + (lane >> 3), c = (lane & 7) ^ (key & 7);
#pragma unroll
    for (int s = 0; s < 2; ++s) {
        const bf16_t* src = p.kb() + (size_t)(krow0 + key) * 512 + (h4 * 2 + s) * 64 + c * 8;
        __builtin_amdgcn_global_load_lds((const unsigned*)src, (LAS unsigned*)(slot + s * 8192 + wave * 1024), 16, 0, 0);
    }
}
__device__ __forceinline__ void attn_dma_v(const P& p, LAS unsigned char* slot, int krow0, int h4, int wave, int lane) {
#pragma unroll
    for (int q = 0; q < 2; ++q) {
        const int pi = wave * 2 + q, db = pi >> 2, j = pi & 3;
        const bf16_t* src = p.vb() + (size_t)(krow0 + 16 * j + (lane >> 2)) * 512 + h4 * 128 + 32 * db + 8 * (lane & 3);
        __builtin_amdgcn_global_load_lds((const unsigned*)src, (LAS unsigned*)(slot + pi * 1024), 16, 0, 0);
    }
}
constexpr int AT_KSLOT = 16384, AT_VOFF = 3 * 16384;

__device__ __forceinline__ void attn_qk(f32x16& s0, f32x16& s1, const LAS unsigned char* kread, const bf16x8 (&qr)[4], int ksw, int h) {
#pragma unroll
    for (int i = 0; i < 16; ++i) { s0[i] = 0.f; s1[i] = 0.f; }
#pragma unroll
    for (int d0 = 0; d0 < 4; ++d0) {
        const int co = ((2 * d0 + h) ^ ksw) * 16;
        const bf16x8 k0 = *(const LAS bf16x8*)(kread + co);
        const bf16x8 k1 = *(const LAS bf16x8*)(kread + 4096 + co);
        s0 = __builtin_amdgcn_mfma_f32_32x32x16_bf16(k0, qr[d0], s0, 0, 0, 0);
        s1 = __builtin_amdgcn_mfma_f32_32x32x16_bf16(k1, qr[d0], s1, 0, 0, 0);
    }
}

__device__ __forceinline__ void attn_unit(const P& p, int l, const AttnUnit& u, LAS unsigned char* lds, float lam, float lam_init) {
    const int tid = opaque_tid(), lane = tid & 63, r = lane & 31, h = lane >> 5;
    const int wave = __builtin_amdgcn_readfirstlane(tid >> 6), s = wave >> 2, w4 = wave & 3;
    const int h4 = u.hs0, NT = u.n0 + u.n1;
    const int qrow = u.qrow0 + w4 * 32 + r;
#define AT_KROW(t) ((t) < u.n0 ? u.kb0 + (t) * 64 : u.kb1 + ((t) - u.n0) * 64)
    attn_dma_k(p, lds, AT_KROW(0), h4, wave, lane);
    attn_dma_v(p, lds + AT_VOFF, AT_KROW(0), h4, wave, lane);
    if (NT > 1) attn_dma_k(p, lds + AT_KSLOT, AT_KROW(1), h4, wave, lane);
    bf16x8 qr[4];
    {
        const bf16_t* qp = p.qb() + (size_t)qrow * 512 + (h4 * 2 + s) * 64 + h * 8;
#pragma unroll
        for (int d0 = 0; d0 < 4; ++d0) qr[d0] = *(const bf16x8*)(qp + d0 * 16);
    }
    f32x16 o[4];
#pragma unroll
    for (int dt = 0; dt < 4; ++dt)
#pragma unroll
        for (int i = 0; i < 16; ++i) o[dt][i] = 0.f;
    float m = 0.f, lsum = 0.f;
    const LAS unsigned char* kread = lds + s * 8192 + r * 128;
    const int ksw = r & 7;
    const LAS unsigned char* vread = lds + AT_VOFF + (4 * h + ((lane & 15) >> 2)) * 64 + ((lane >> 4) & 1) * 32 + (lane & 3) * 8;
    asm volatile("s_waitcnt vmcnt(0)" ::: "memory");
    __builtin_amdgcn_s_barrier();
    f32x16 s0, s1;
    attn_qk(s0, s1, kread, qr, ksw, h);
    {
        float mx = fmaxf(s0[0], s1[0]);
#pragma unroll
        for (int i = 1; i < 16; ++i) mx = fmaxf(mx, fmaxf(s0[i], s1[i]));
        m = fmaxf(mx, swap32(mx));
    }
    int kslot_n = AT_KSLOT, kslot_nn = 2 * AT_KSLOT;
    for (int t = 0; t < NT; ++t) {
        if (t + 2 < NT) attn_dma_k(p, lds + kslot_nn, AT_KROW(t + 2), h4, wave, lane);
        if (t + 1 < NT) attn_dma_v(p, lds + AT_VOFF + ((t + 1) & 1) * 16384, AT_KROW(t + 1), h4, wave, lane);
        f32x16 n0, n1;
        if (t + 1 < NT) attn_qk(n0, n1, kread + kslot_n, qr, ksw, h);
        {
            typedef float f2_t __attribute__((ext_vector_type(2)));
            const f2_t m2 = (f2_t){m, m};
#pragma unroll
            for (int i = 0; i < 16; i += 2) {
                const f2_t a = (f2_t){s0[i], s0[i + 1]} - m2, b = (f2_t){s1[i], s1[i + 1]} - m2;
                s0[i] = a.x; s0[i + 1] = a.y; s1[i] = b.x; s1[i + 1] = b.y;
            }
            float mx0 = fmaxf(fmaxf(s0[0], s1[0]), s0[1]), mx1 = fmaxf(fmaxf(s0[2], s1[2]), s0[3]), mx2 = fmaxf(fmaxf(s0[4], s1[4]), s0[5]), mx3 = fmaxf(fmaxf(s0[6], s1[6]), s0[7]);
            mx0 = fmaxf(fmaxf(mx0, s1[1]), s0[8]);  mx1 = fmaxf(fmaxf(mx1, s1[3]), s0[9]);  mx2 = fmaxf(fmaxf(mx2, s1[5]), s0[10]); mx3 = fmaxf(fmaxf(mx3, s1[7]), s0[11]);
            mx0 = fmaxf(fmaxf(mx0, s1[8]), s0[12]); mx1 = fmaxf(fmaxf(mx1, s1[9]), s0[13]); mx2 = fmaxf(fmaxf(mx2, s1[10]), s0[14]); mx3 = fmaxf(fmaxf(mx3, s1[11]), s0[15]);
            mx0 = fmaxf(fmaxf(mx0, s1[12]), s1[13]); mx1 = fmaxf(fmaxf(mx1, s1[14]), s1[15]);
            float mx = fmaxf(fmaxf(mx0, mx1), fmaxf(mx2, mx3));
            mx = fmaxf(mx, swap32(mx));
            if (__any(mx > 8.0f)) {
                const float dl = fmaxf(mx, 0.f), alpha = __builtin_amdgcn_exp2f(-dl);
                m += dl; lsum *= alpha;
#pragma unroll
                for (int dt = 0; dt < 4; ++dt)
#pragma unroll
                    for (int i = 0; i < 16; ++i) o[dt][i] *= alpha;
#pragma unroll
                for (int i = 0; i < 16; ++i) { s0[i] -= dl; s1[i] -= dl; }
            }
            f2_t ps2 = (f2_t){0.f, 0.f};
#pragma unroll
            for (int i = 0; i < 16; i += 2) {
                const f2_t a = (f2_t){__builtin_amdgcn_exp2f(s0[i]), __builtin_amdgcn_exp2f(s0[i + 1])}, b = (f2_t){__builtin_amdgcn_exp2f(s1[i]), __builtin_amdgcn_exp2f(s1[i + 1])};
                s0[i] = a.x; s0[i + 1] = a.y; s1[i] = b.x; s1[i + 1] = b.y;
                ps2 += a; ps2 += b;
            }
            lsum += ps2.x + ps2.y;
        }
        bf16x8 pw[4];
#pragma unroll
        for (int ks = 0; ks < 4; ++ks) {
            v4u w;
            if (ks < 2) { w.x = pkbf(s0[8 * ks + 0], s0[8 * ks + 1]); w.y = pkbf(s0[8 * ks + 2], s0[8 * ks + 3]); w.z = pkbf(s0[8 * ks + 4], s0[8 * ks + 5]); w.w = pkbf(s0[8 * ks + 6], s0[8 * ks + 7]); }
            else { const int b = 8 * (ks - 2); w.x = pkbf(s1[b + 0], s1[b + 1]); w.y = pkbf(s1[b + 2], s1[b + 3]); w.z = pkbf(s1[b + 4], s1[b + 5]); w.w = pkbf(s1[b + 6], s1[b + 7]); }
            pw[ks] = __builtin_bit_cast(bf16x8, w);
        }
        {
            const int va = (int)(unsigned)(size_t)vread + (t & 1) * 16384;
            s16x4 la[4], ha[4], lb[4], hb_[4];
#define AT_TR(dst, off) asm volatile("ds_read_b64_tr_b16 %0, %1 offset:%c2" : "=&v"(dst) : "v"(va), "i"(off) : "memory")
#define AT_VG(L, H, KS) do { _Pragma("unroll") for (int dt = 0; dt < 4; ++dt) { AT_TR(L[dt], dt * 4096 + (KS) * 1024); AT_TR(H[dt], dt * 4096 + (KS) * 1024 + 512); } } while (0)
#define AT_WAIT(N, L, H) asm volatile("s_waitcnt lgkmcnt(" #N ")" : "+v"(L[0]), "+v"(L[1]), "+v"(L[2]), "+v"(L[3]), "+v"(H[0]), "+v"(H[1]), "+v"(H[2]), "+v"(H[3]) :: "memory")
#define AT_PVG(L, H, KS) do { _Pragma("unroll") for (int dt = 0; dt < 4; ++dt) { const bf16x8 vf_ = (bf16x8){L[dt][0], L[dt][1], L[dt][2], L[dt][3], H[dt][0], H[dt][1], H[dt][2], H[dt][3]}; \
            o[dt] = __builtin_amdgcn_mfma_f32_32x32x16_bf16(vf_, pw[KS], o[dt], 0, 0, 0); } } while (0)
            AT_VG(la, ha, 0); AT_VG(lb, hb_, 1);
            AT_WAIT(8, la, ha); AT_PVG(la, ha, 0);
            AT_VG(la, ha, 2);
            AT_WAIT(8, lb, hb_); AT_PVG(lb, hb_, 1);
            AT_VG(lb, hb_, 3);
            AT_WAIT(8, la, ha); AT_PVG(la, ha, 2);
            AT_WAIT(0, lb, hb_); AT_PVG(lb, hb_, 3);
#undef AT_TR
#undef AT_VG
#undef AT_WAIT
#undef AT_PVG
        }
        s0 = n0; s1 = n1;
        kslot_n = kslot_nn; kslot_nn = (kslot_n + AT_KSLOT) % (3 * AT_KSLOT);
        asm volatile("s_waitcnt vmcnt(0)" ::: "memory");
        __builtin_amdgcn_s_barrier();
    }
#undef AT_KROW
    const float inv = 1.0f / (lsum + swap32(lsum));
    __syncthreads();
    LAS float* xch = (LAS float*)lds + w4 * 4096;
    if (s == 1) {
#pragma unroll
        for (int dt = 0; dt < 4; ++dt)
#pragma unroll
            for (int i = 0; i < 16; ++i) xch[(dt * 16 + i) * 64 + lane] = o[dt][i] * inv;
    }
    __syncthreads();
    if (s == 0) {
        float ss = 0.f;
#pragma unroll
        for (int dt = 0; dt < 4; ++dt)
#pragma unroll
            for (int i = 0; i < 16; ++i) { const float v = o[dt][i] * inv - lam * xch[(dt * 16 + i) * 64 + lane]; o[dt][i] = v; ss += v * v; }
        ss += swap32(ss);
        const float rn = rsqrtf(ss * (1.0f / VD) + EPS) * (1.0f - lam_init);
        bf16_t* dst = p.mixb() + (size_t)qrow * D + h4 * VD + 4 * h;
        const float* gp = p.sp_subln() + l * VD + 4 * h;
#pragma unroll
        for (int dt = 0; dt < 4; ++dt)
#pragma unroll
            for (int i4 = 0; i4 < 4; ++i4) {
                const f32x4 g = *(const f32x4*)(gp + 32 * dt + 8 * i4);
                v2u w; w.x = pkbf(o[dt][4 * i4 + 0] * rn * g[0], o[dt][4 * i4 + 1] * rn * g[1]); w.y = pkbf(o[dt][4 * i4 + 2] * rn * g[2], o[dt][4 * i4 + 3] * rn * g[3]);
                *(v2u*)(dst + 32 * dt + 8 * i4) = w;
            }
    }
    __syncthreads();
}

__device__ __forceinline__ void attn_phase(const P& p, int l, LAS unsigned char* lds, bool with_ctx) {
    const int lane = threadIdx.x & 63;
    const float lam = p.sp_lam()[l * 2], lam_init = p.sp_lam()[l * 2 + 1];
    const int bx = blockIdx.x, G = gridDim.x;
    for (int i = bx; i < 512; i += G) {
        const int combo = i & 7, qblk = i >> 3, b = combo >> 2, h4 = combo & 3;
        AttnUnit u{b * SEQ + qblk * AT_QB, h4, b * SEQ, SEQ / 64, RL + b * CTX, CTX / 64};
        attn_unit(p, l, u, lds, lam, lam_init);
    }
    if (with_ctx) {
        for (int i = bx; i < 16; i += G) {
            const int combo = i & 7, qblk = i >> 3, b = combo >> 2, h4 = combo & 3;
            AttnUnit u{RL + b * CTX + qblk * AT_QB, h4, RL + b * CTX, CTX / 64, 0, 0};
            attn_unit(p, l, u, lds, lam, lam_init);
        }
    }
}

typedef float f32x4v __attribute__((ext_vector_type(4)));
constexpr int NPOS = 132, NPOSP = 144;
constexpr int ES_LD = 132, HB_LD = 136;
constexpr int U_LD = 264;

__device__ __forceinline__ int ssm_rowbase(int b, int dr, int n) {
    if (dr == 0) return n < 4 ? RL + b * CTX + 64 * n : b * SEQ + 64 * (n - 4);
    return n < 4 ? RL + b * CTX + 64 * (3 - n) : b * SEQ + 64 * (131 - n);
}
__device__ __forceinline__ void ssm_zoh(const P& p, int cb, int pp, float& lre, float& lim, float& step, float& cr, float& ci) {
    lre = p.lre()[cb * PS + pp]; lim = p.lim()[cb * PS + pp]; step = expf(p.lstep()[cb]);
    const float er = expf(lre * step), ar = er * cosf(lim * step), ai = er * sinf(lim * step);
    const float nr = ar - 1.0f, den = lre * lre + lim * lim;
    cr = (nr * lre + ai * lim) / den; ci = (ai * lre - nr * lim) / den;
}
__device__ __forceinline__ void ssm_apow(float lre, float lim, float step, float e, float& pr, float& pi) {
    const float mag = expf(lre * step * e), ang = lim * step * e;
    pr = mag * cosf(ang); pi = mag * sinf(ang);
}

__device__ __forceinline__ void ssm_tables(const P& p, LAS unsigned char* lds) {
    const int tid = opaque_tid(), lane = tid & 63, wave = __builtin_amdgcn_readfirstlane(tid >> 6);
    const int G = gridDim.x, gw = blockIdx.x * NWAVES + wave, NGW = G * NWAVES;
    for (int it = gw; it < 64 * 64 * 2; it += NGW) {
        const int which = it >= 64 * 64, r = it & (64 * 64 - 1), cb = r >> 6, x = r & 63, dr = (cb >> 4) & 1;
        float lre, lim, step, cr, ci; ssm_zoh(p, cb, lane, lre, lim, step, cr, ci);
        if (!which) {
            float pr, pi; ssm_apow(lre, lim, step, (float)(dr ? x : 63 - x), pr, pi);
            unsigned wr[8], wi[8];
#pragma unroll
            for (int hh = 0; hh < 16; hh += 2) {
                float zr[2], zi[2];
#pragma unroll
                for (int q = 0; q < 2; ++q) {
                    const float br = p.bre()[((size_t)cb * PS + lane) * SG + hh + q], bi = p.bim()[((size_t)cb * PS + lane) * SG + hh + q];
                    const float bbr = cr * br - ci * bi, bbi = cr * bi + ci * br;
                    zr[q] = pr * bbr - pi * bbi; zi[q] = pr * bbi + pi * bbr;
                }
                wr[hh >> 1] = pkbf(zr[0], zr[1]); wi[hh >> 1] = pkbf(zi[0], zi[1]);
            }
            const int ks_ = x >> 1, fqb = (x & 1) * 2;
            bf16_t* d0 = p.ssm_we() + ((((size_t)cb * 8 + (lane >> 4)) * 32 + ks_) * 64 + fqb * 16 + (lane & 15)) * 8;
            bf16_t* d1 = p.ssm_we() + ((((size_t)cb * 8 + 4 + (lane >> 4)) * 32 + ks_) * 64 + fqb * 16 + (lane & 15)) * 8;
            *(v4u*)d0 = (v4u){wr[0], wr[1], wr[2], wr[3]}; *(v4u*)(d0 + 128) = (v4u){wr[4], wr[5], wr[6], wr[7]};
            *(v4u*)d1 = (v4u){wi[0], wi[1], wi[2], wi[3]}; *(v4u*)(d1 + 128) = (v4u){wi[4], wi[5], wi[6], wi[7]};
        } else {
            float pr, pi; ssm_apow(lre, lim, step, (float)(dr ? 64 - x : x + 1), pr, pi);
            for (int hh = 0; hh < 16; ++hh) {
                const float c_r = p.cre()[((size_t)cb * SG + hh) * PS + lane], c_i = p.cim()[((size_t)cb * SG + hh) * PS + lane];
                bf16_t* d = p.ssm_wc() + ((size_t)cb * 1024 + x * 16 + hh) * 128;
                d[lane] = (bf16_t)(pkbf(c_r * pr - c_i * pi, 0.f) & 0xffff);
                d[64 + lane] = (bf16_t)(pkbf(-c_r * pi - c_i * pr, 0.f) & 0xffff);
            }
        }
    }
    LAS float* zs = (LAS float*)lds + wave * (2 * 64 * 16);
    for (int it = gw; it < 64 * 64; it += NGW) {
        const int cb = it >> 6, j = it & 63;
        float lre, lim, step, cr, ci; ssm_zoh(p, cb, lane, lre, lim, step, cr, ci);
        float pr, pi; ssm_apow(lre, lim, step, (float)j, pr, pi);
#pragma unroll
        for (int hh = 0; hh < 16; ++hh) {
            const float br = p.bre()[((size_t)cb * PS + lane) * SG + hh], bi = p.bim()[((size_t)cb * PS + lane) * SG + hh];
            const float bbr = cr * br - ci * bi, bbi = cr * bi + ci * br;
            zs[lane * 16 + hh] = pr * bbr - pi * bbi; zs[1024 + lane * 16 + hh] = pr * bbi + pi * bbr;
        }
        asm volatile("s_waitcnt lgkmcnt(0)" ::: "memory");
        const int h = lane >> 2, h0 = (lane & 3) * 4;
        float acc[4] = {0.f, 0.f, 0.f, 0.f};
        for (int pp = 0; pp < PS; ++pp) {
            const float c_r = p.cre()[((size_t)cb * SG + h) * PS + pp], c_i = p.cim()[((size_t)cb * SG + h) * PS + pp];
            const f32x4v zr = *(const LAS f32x4v*)(zs + pp * 16 + h0), zi = *(const LAS f32x4v*)(zs + 1024 + pp * 16 + h0);
#pragma unroll
            for (int e = 0; e < 4; ++e) acc[e] += c_r * zr[e] - c_i * zi[e];
        }
        v2u w; w.x = pkbf(acc[0], acc[1]); w.y = pkbf(acc[2], acc[3]);
        *(v2u*)(p.ssm_km() + (((size_t)cb * 64 + j) * 16 + h) * 16 + h0) = w;
        asm volatile("s_waitcnt lgkmcnt(0)" ::: "memory");
    }
}

__device__ __forceinline__ void ssm_a_item(const P& p, int l, int b, int dr, int g, LAS unsigned char* lds) {
    const int tid = opaque_tid(), lane = tid & 63, fr = lane & 15, fq = lane >> 4;
    const int wave = __builtin_amdgcn_readfirstlane(tid >> 6);
    const int cb = (l * 2 + dr) * 16 + g;
    LAS float* Es = (LAS float*)lds;
    LAS bf16_t* Hb = (LAS bf16_t*)(lds + NPOSP * ES_LD * 4);
    {
        pg8::f32x4 acc[9];
#pragma unroll
        for (int nt = 0; nt < 9; ++nt) acc[nt] = (pg8::f32x4){0.f, 0.f, 0.f, 0.f};
        const bf16_t* We = p.ssm_we() + (((size_t)cb * 8 + wave) * 32 * 64 + lane) * 8;
        constexpr int BS_LD = 144;
        LAS unsigned char* Bs = lds + NPOSP * ES_LD * 4;
        const bf16_t* sp[3];
#pragma unroll
        for (int i = 0; i < 3; ++i) { const int pid = tid + i * (NWAVES * 64); int pos = pid >> 3; pos = pos < NPOS ? pos : NPOS - 1; sp[i] = p.ub() + ((size_t)g * R + ssm_rowbase(b, dr, pos)) * 16 + (pid & 7) * 8; }
        v4u st[3], sn[3];
#pragma unroll
        for (int i = 0; i < 3; ++i) if (tid + i * (NWAVES * 64) < NPOSP * 8) { st[i] = *(const v4u*)sp[i]; sn[i] = *(const v4u*)(sp[i] + 64); }
#pragma unroll
        for (int i = 0; i < 3; ++i) { const int pid = tid + i * (NWAVES * 64); if (pid < NPOSP * 8) *(LAS v4u*)(Bs + (pid >> 3) * BS_LD + (pid & 7) * 16) = st[i]; }
        bf16x8 a0 = *(const bf16x8*)(We), a1 = *(const bf16x8*)(We + 512), n0 = *(const bf16x8*)(We + 2 * 512), n1 = *(const bf16x8*)(We + 3 * 512);
        __syncthreads();
#pragma unroll 1
        for (int c = 0; c < 16; ++c) {
            const bool more = c + 1 < 16, more2 = c + 2 < 16;
#pragma unroll
            for (int i = 0; i < 3; ++i) st[i] = sn[i];
            bf16x8 m0 = n0, m1 = n1;
            if (more2) {
#pragma unroll
                for (int i = 0; i < 3; ++i) if (tid + i * (NWAVES * 64) < NPOSP * 8) sn[i] = *(const v4u*)(sp[i] + (size_t)(c + 2) * 64);
                m0 = *(const bf16x8*)(We + (2 * c + 4) * 512); m1 = *(const bf16x8*)(We + (2 * c + 5) * 512);
            }
            const LAS unsigned char* bb = Bs + (c & 1) * (NPOSP * BS_LD) + fr * BS_LD + fq * 16;
#pragma unroll
            for (int nt = 0; nt < 9; ++nt) {
                const bf16x8 b0 = *(const LAS bf16x8*)(bb + nt * 16 * BS_LD), b1 = *(const LAS bf16x8*)(bb + nt * 16 * BS_LD + 64);
                acc[nt] = __builtin_amdgcn_mfma_f32_16x16x32_bf16(a0, b0, acc[nt], 0, 0, 0);
                acc[nt] = __builtin_amdgcn_mfma_f32_16x16x32_bf16(a1, b1, acc[nt], 0, 0, 0);
            }
            if (more) {
#pragma unroll
                for (int i = 0; i < 3; ++i) { const int pid = tid + i * (NWAVES * 64); if (pid < NPOSP * 8) *(LAS v4u*)(Bs + ((c + 1) & 1) * (NPOSP * BS_LD) + (pid >> 3) * BS_LD + (pid & 7) * 16) = st[i]; }
            }
            a0 = n0; a1 = n1; n0 = m0; n1 = m1;
            __syncthreads();
        }
#pragma unroll
        for (int nt = 0; nt < 9; ++nt) *(LAS pg8::f32x4*)(Es + (16 * nt + fr) * ES_LD + wave * 16 + 4 * fq) = acc[nt];
    }
    __syncthreads();
    if (wave == 0) {
        const float a64r = p.sp_a64()[(cb * PS + lane) * 2], a64i = p.sp_a64()[(cb * PS + lane) * 2 + 1];
        float hr = 0.f, hi = 0.f;
        for (int k0 = 0; k0 < NPOS; k0 += 4) {
            float er[4], ei[4];
#pragma unroll
            for (int q = 0; q < 4; ++q) { er[q] = Es[(k0 + q) * ES_LD + lane]; ei[q] = Es[(k0 + q) * ES_LD + 64 + lane]; }
#pragma unroll
            for (int q = 0; q < 4; ++q) {
                const int k = k0 + q;
                Hb[k * HB_LD + lane] = (bf16_t)(pkbf(hr, 0.f) & 0xffff); Hb[k * HB_LD + 64 + lane] = (bf16_t)(pkbf(hi, 0.f) & 0xffff);
                const float nr = a64r * hr - a64i * hi + er[q], ni = a64r * hi + a64i * hr + ei[q];
                hr = nr; hi = ni;
            }
        }
        for (int k = NPOS; k < NPOSP; ++k) { Hb[k * HB_LD + lane] = 0; Hb[k * HB_LD + 64 + lane] = 0; }
    }
    __syncthreads();
    {
        const bf16_t* Wc = p.ssm_wc() + ((size_t)cb * 1024 + fr) * 128 + fq * 8;
        bf16x8 an[4], am[4];
#pragma unroll
        for (int ks = 0; ks < 4; ++ks) { an[ks] = *(const bf16x8*)(Wc + (size_t)(wave * 8) * 16 * 128 + ks * 32); am[ks] = *(const bf16x8*)(Wc + (size_t)(wave * 8 + 1) * 16 * 128 + ks * 32); }
#pragma unroll 1
        for (int tt = 0; tt < 8; ++tt) {
            const int t = wave * 8 + tt;
            bf16x8 a[4];
#pragma unroll
            for (int ks = 0; ks < 4; ++ks) { a[ks] = an[ks]; an[ks] = am[ks]; }
            if (tt + 2 < 8) {
#pragma unroll
                for (int ks = 0; ks < 4; ++ks) am[ks] = *(const bf16x8*)(Wc + (size_t)(t + 2) * 16 * 128 + ks * 32);
            }
#pragma unroll
            for (int nt = 0; nt < 9; ++nt) {
                pg8::f32x4 acc = (pg8::f32x4){0.f, 0.f, 0.f, 0.f};
#pragma unroll
                for (int ks = 0; ks < 4; ++ks) {
                    const bf16x8 bv = *(const LAS bf16x8*)(Hb + (16 * nt + fr) * HB_LD + ks * 32 + fq * 8);
                    acc = __builtin_amdgcn_mfma_f32_16x16x32_bf16(a[ks], bv, acc, 0, 0, 0);
                }
                const int n = 16 * nt + fr;
                if (n < NPOS) *(pg8::f32x4*)(p.yc() + ((size_t)dr * R + ssm_rowbase(b, dr, n) + t) * 256 + g * 16 + 4 * fq) = acc;
            }
        }
    }
    __syncthreads();
}

__device__ __forceinline__ void ssm_b_unit(const P& p, int l, int row0, int seq0, int nseq, LAS unsigned char* lds) {
    const int tid = opaque_tid(), lane = tid & 63, fr = lane & 15, fq = lane >> 4;
    const int wave = __builtin_amdgcn_readfirstlane(tid >> 6);
    LAS bf16_t* U = (LAS bf16_t*)lds;
    LAS bf16_t* YG = U + 64 * U_LD;
    LAS bf16_t* PW = YG + 64 * U_LD;
    LAS bf16_t* DF = PW + 80 * U_LD;
    for (int i = tid; i < 64 * 32; i += NWAVES * 64) { const int rr = i >> 5, c8 = i & 31; *(LAS v4u*)(U + rr * U_LD + c8 * 8) = *(const v4u*)(p.ub() + ((size_t)(c8 >> 1) * R + row0 + rr) * 16 + (c8 & 1) * 8); }
    for (int i = tid; i < 80 * 32; i += NWAVES * 64) {
        const int rr = i >> 5, c8 = i & 31, row = row0 - 8 + rr;
        v4u v = (v4u){0u, 0u, 0u, 0u};
        if (row >= seq0 && row < seq0 + nseq) v = *(const v4u*)(p.pb() + (size_t)row * 256 + c8 * 8);
        *(LAS v4u*)(PW + rr * U_LD + c8 * 8) = v;
    }
    __syncthreads();
#pragma unroll 1
    for (int gg = 0; gg < 2; ++gg) {
        const int g = wave * 2 + gg;
        const int cbf = (l * 2 + 0) * 16 + g, cbb = (l * 2 + 1) * 16 + g;
        pg8::f32x4 acc[4];
#pragma unroll
        for (int nt = 0; nt < 4; ++nt) acc[nt] = (pg8::f32x4){0.f, 0.f, 0.f, 0.f};
        const bf16_t* kf = p.ssm_km() + (((size_t)cbf * 64 + (fq >> 1)) * 16 + fr) * 16 + (fq & 1) * 8;
        const bf16_t* kb = p.ssm_km() + (((size_t)cbb * 64 + (fq >> 1)) * 16 + fr) * 16 + (fq & 1) * 8;
        const LAS bf16_t* ucol = U + g * 16 + (fq & 1) * 8;
        bf16x8 afr[4], abr[4];
#pragma unroll
        for (int i = 0; i < 4; ++i) { afr[i] = *(const bf16x8*)(kf + (size_t)(2 * i) * 256); abr[i] = *(const bf16x8*)(kb + (size_t)(2 * i) * 256); }
#pragma unroll 1
        for (int ks0 = 0; ks0 < 32; ks0 += 4) {
#pragma unroll
            for (int i = 0; i < 4; ++i) {
                const int ks = ks0 + i;
                const bf16x8 af = afr[i], ab = abr[i];
                if (ks + 4 < 32) { afr[i] = *(const bf16x8*)(kf + (size_t)(2 * (ks + 4)) * 256); abr[i] = *(const bf16x8*)(kb + (size_t)(2 * (ks + 4)) * 256); }
                const int j = 2 * ks + (fq >> 1);
#pragma unroll
                for (int nt = 0; nt < 4; ++nt) {
                    const int t = 16 * nt + fr;
                    if (ks < 8 * nt + 8) {
                        const int rr = t - j; const int rc = rr < 0 ? 0 : rr;
                        bf16x8 bv = *(const LAS bf16x8*)(ucol + rc * U_LD);
                        if (rr < 0) bv = (bf16x8){0, 0, 0, 0, 0, 0, 0, 0};
                        acc[nt] = __builtin_amdgcn_mfma_f32_16x16x32_bf16(af, bv, acc[nt], 0, 0, 0);
                    }
                    if (ks < 32 - 8 * nt) {
                        const int rr = t + j; const int rc = rr > 63 ? 63 : rr;
                        bf16x8 bv = *(const LAS bf16x8*)(ucol + rc * U_LD);
                        if (rr > 63) bv = (bf16x8){0, 0, 0, 0, 0, 0, 0, 0};
                        acc[nt] = __builtin_amdgcn_mfma_f32_16x16x32_bf16(ab, bv, acc[nt], 0, 0, 0);
                    }
                }
            }
        }
        const int ch = g * 16 + 4 * fq;
        const pg8::f32x4 d4 = *(const pg8::f32x4*)(p.sp_ssmd() + l * SSM_W + ch);
#pragma unroll
        for (int nt = 0; nt < 4; ++nt) {
            const int t = 16 * nt + fr;
            const pg8::f32x4 y0 = *(const pg8::f32x4*)(p.yc() + ((size_t)(row0 + t)) * 256 + ch);
            const pg8::f32x4 y1 = *(const pg8::f32x4*)(p.yc() + ((size_t)R + row0 + t) * 256 + ch);
            const v2u uu = *(const LAS v2u*)(U + t * U_LD + ch);
            const float u0 = __uint_as_float(uu.x << 16), u1 = __uint_as_float(uu.x & 0xffff0000u), u2 = __uint_as_float(uu.y << 16), u3 = __uint_as_float(uu.y & 0xffff0000u);
            const float v0 = gelu_exact(acc[nt][0] + y0[0] + y1[0] + d4[0] * u0), v1 = gelu_exact(acc[nt][1] + y0[1] + y1[1] + d4[1] * u1);
            const float v2 = gelu_exact(acc[nt][2] + y0[2] + y1[2] + d4[2] * u2), v3 = gelu_exact(acc[nt][3] + y0[3] + y1[3] + d4[3] * u3);
            v2u w; w.x = pkbf(v0, v1); w.y = pkbf(v2, v3);
            *(LAS v2u*)(YG + t * U_LD + ch) = w;
        }
    }
    {
        const int tabs0 = row0 - seq0;
#pragma unroll 1
        for (int it = 0; it < 4; ++it) {
            const int idx = tid + it * (NWAVES * 64), t = idx >> 5, oc = idx & 31, gi = oc >> 3, half = 1 << gi;
            const int ta = tabs0 + t;
            int lo = ta - half; lo = lo < 0 ? 0 : lo; int hi = ta + half; hi = hi > nseq ? nseq : hi;
            float sacc[8] = {0.f, 0.f, 0.f, 0.f, 0.f, 0.f, 0.f, 0.f};
            for (int a = lo; a < hi; ++a) {
                const v4u v = *(const LAS v4u*)(PW + (a - tabs0 + 8) * U_LD + oc * 8);
                sacc[0] += __uint_as_float(v.x << 16); sacc[1] += __uint_as_float(v.x & 0xffff0000u); sacc[2] += __uint_as_float(v.y << 16); sacc[3] += __uint_as_float(v.y & 0xffff0000u);
                sacc[4] += __uint_as_float(v.z << 16); sacc[5] += __uint_as_float(v.z & 0xffff0000u); sacc[6] += __uint_as_float(v.w << 16); sacc[7] += __uint_as_float(v.w & 0xffff0000u);
            }
            const float rc = 1.0f / (float)(hi - lo);
            const v4u c = *(const LAS v4u*)(PW + (t + 8) * U_LD + oc * 8);
            v4u o;
            o.x = pkbf(sacc[0] * rc - __uint_as_float(c.x << 16), sacc[1] * rc - __uint_as_float(c.x & 0xffff0000u));
            o.y = pkbf(sacc[2] * rc - __uint_as_float(c.y << 16), sacc[3] * rc - __uint_as_float(c.y & 0xffff0000u));
            o.z = pkbf(sacc[4] * rc - __uint_as_float(c.z << 16), sacc[5] * rc - __uint_as_float(c.z & 0xffff0000u));
            o.w = pkbf(sacc[6] * rc - __uint_as_float(c.w << 16), sacc[7] * rc - __uint_as_float(c.w & 0xffff0000u));
            *(LAS v4u*)(DF + t * U_LD + oc * 8) = o;
        }
    }
    __syncthreads();
    {
        const bf16_t* wg = p.wglu_t() + (size_t)l * SSM_W * SSM_W;
#pragma unroll 1
        for (int jj = 0; jj < 2; ++jj) {
            const int jt = wave * 2 + jj;
            pg8::f32x4 acc[4];
#pragma unroll
            for (int nt = 0; nt < 4; ++nt) acc[nt] = (pg8::f32x4){0.f, 0.f, 0.f, 0.f};
#pragma unroll 2
            for (int ks = 0; ks < 8; ++ks) {
                const bf16x8 a = *(const bf16x8*)(wg + (size_t)(16 * jt + fr) * SSM_W + ks * 32 + fq * 8);
#pragma unroll
                for (int nt = 0; nt < 4; ++nt) {
                    const bf16x8 bv = *(const LAS bf16x8*)(YG + (16 * nt + fr) * U_LD + ks * 32 + fq * 8);
                    acc[nt] = __builtin_amdgcn_mfma_f32_16x16x32_bf16(a, bv, acc[nt], 0, 0, 0);
                }
            }
#pragma unroll
            for (int nt = 0; nt < 4; ++nt) {
                const int t = 16 * nt + fr, j0 = 16 * jt + 4 * fq;
                const v2u yy = *(const LAS v2u*)(YG + t * U_LD + j0);
                const float y0 = __uint_as_float(yy.x << 16), y1 = __uint_as_float(yy.x & 0xffff0000u), y2 = __uint_as_float(yy.y << 16), y3 = __uint_as_float(yy.y & 0xffff0000u);
                v2u w;
                w.x = pkbf(y0 / (1.0f + __expf(-acc[nt][0])), y1 / (1.0f + __expf(-acc[nt][1])));
                w.y = pkbf(y2 / (1.0f + __expf(-acc[nt][2])), y3 / (1.0f + __expf(-acc[nt][3])));
                *(v2u*)(p.mixb() + (size_t)(row0 + t) * D + 512 + j0) = w;
            }
        }
    }
    {
        const int gi = wave >> 1;
        const bf16_t* wp = p.poolw_t() + ((size_t)(l * 4 + gi) * 64) * 64;
#pragma unroll 1
        for (int ee = 0; ee < 2; ++ee) {
            const int et = (wave & 1) * 2 + ee;
            pg8::f32x4 acc[4];
#pragma unroll
            for (int nt = 0; nt < 4; ++nt) acc[nt] = (pg8::f32x4){0.f, 0.f, 0.f, 0.f};
#pragma unroll
            for (int ks = 0; ks < 2; ++ks) {
                const bf16x8 a = *(const bf16x8*)(wp + (size_t)(16 * et + fr) * 64 + ks * 32 + fq * 8);
#pragma unroll
                for (int nt = 0; nt < 4; ++nt) {
                    const bf16x8 bv = *(const LAS bf16x8*)(DF + (16 * nt + fr) * U_LD + gi * 64 + ks * 32 + fq * 8);
                    acc[nt] = __builtin_amdgcn_mfma_f32_16x16x32_bf16(a, bv, acc[nt], 0, 0, 0);
                }
            }
            const int e0 = gi * 64 + 16 * et + 4 * fq;
            const pg8::f32x4 sc = *(const pg8::f32x4*)(p.sp_poolsc() + l * POOL_W + e0);
#pragma unroll
            for (int nt = 0; nt < 4; ++nt) {
                const int t = 16 * nt + fr;
                v2u w; w.x = pkbf(acc[nt][0] * sc[0], acc[nt][1] * sc[1]); w.y = pkbf(acc[nt][2] * sc[2], acc[nt][3] * sc[3]);
                *(v2u*)(p.mixb() + (size_t)(row0 + t) * D + 768 + e0) = w;
            }
        }
    }
    __syncthreads();
}

__device__ __forceinline__ unsigned f2ord(float f) { const unsigned b = __float_as_uint(f); return b ^ ((unsigned)((int)b >> 31) | 0x80000000u); }
__device__ __forceinline__ float ord2f(unsigned u) { const unsigned b = (u & 0x80000000u) ? (u ^ 0x80000000u) : ~u; return __uint_as_float(b); }
__device__ __forceinline__ void ce_desc(unsigned& a, unsigned& b) { const unsigned mx = a > b ? a : b, mn = a > b ? b : a; a = mx; b = mn; }
__device__ __forceinline__ void sort16_desc(unsigned (&v)[16]) {
#pragma unroll
    for (int k = 2; k <= 16; k <<= 1)
#pragma unroll
        for (int j = k >> 1; j > 0; j >>= 1)
#pragma unroll
            for (int i = 0; i < 16; ++i) {
                const int lth = i ^ j;
                if (lth > i) { if ((i & k) == 0) ce_desc(v[i], v[lth]); else ce_desc(v[lth], v[i]); }
            }
}
__device__ __forceinline__ void merge16_desc(unsigned (&a)[16], const unsigned (&b)[16]) {
#pragma unroll
    for (int i = 0; i < 16; ++i) a[i] = a[i] > b[15 - i] ? a[i] : b[15 - i];
#pragma unroll
    for (int j = 8; j > 0; j >>= 1)
#pragma unroll
        for (int i = 0; i < 16; ++i) { const int lth = i ^ j; if (lth > i) ce_desc(a[i], a[lth]); }
}
__device__ __forceinline__ unsigned swap32u(unsigned v) {
    auto rr = __builtin_amdgcn_permlane32_swap(v, v, false, false);
    return (threadIdx.x & 32) ? rr[0] : rr[1];
}

__device__ __forceinline__ void peer_score_tile(const P& p, int l, int row0, int rmax, LAS unsigned char* lds, LAS unsigned short* eid, LAS float* gw) {
    const int tid = opaque_tid(), lane = tid & 63, r = lane & 31, h = lane >> 5;
    const int hd = __builtin_amdgcn_readfirstlane(tid >> 6);
    int row = row0 + r; row = row < rmax ? row : rmax - 1;
    unsigned top[2][16];
    bf16x8 qf[2][8];
    {
        const bf16_t* qp = p.qpb() + (size_t)row * (PH * QD) + hd * QD + h * 8;
#pragma unroll
        for (int c = 0; c < 2; ++c)
#pragma unroll
            for (int ks = 0; ks < 8; ++ks) qf[c][ks] = *(const bf16x8*)(qp + c * KD + ks * 16);
    }
#pragma unroll
    for (int c = 0; c < 2; ++c) {
        f32x16 acc[4];
#pragma unroll
        for (int nb = 0; nb < 4; ++nb)
#pragma unroll
            for (int i = 0; i < 16; ++i) acc[nb][i] = 0.f;
        const bf16_t* kp = p.keysb() + (size_t)((l * PH + hd) * 2 + c) * NK * KD + lane * 8;
#pragma unroll
        for (int ks = 0; ks < 8; ++ks) {
#pragma unroll
            for (int nb = 0; nb < 4; ++nb) {
                const bf16x8 kf = *(const bf16x8*)(kp + (nb * 8 + ks) * 512);
                acc[nb] = __builtin_amdgcn_mfma_f32_32x32x16_bf16(kf, qf[c][ks], acc[nb], 0, 0, 0);
            }
        }
        unsigned cur[16];
#pragma unroll
        for (int nb = 0; nb < 4; ++nb) {
            unsigned v[16];
#pragma unroll
            for (int i = 0; i < 16; ++i) { const int nk = 32 * nb + (i & 3) + 8 * (i >> 2) + 4 * h; v[i] = (f2ord(acc[nb][i]) & ~0x7Fu) | (unsigned)(127 - nk); }
            sort16_desc(v);
            if (nb == 0) {
#pragma unroll
                for (int i = 0; i < 16; ++i) cur[i] = v[i];
            } else merge16_desc(cur, v);
        }
        unsigned oth[16];
#pragma unroll
        for (int i = 0; i < 16; ++i) oth[i] = swap32u(cur[i]);
        merge16_desc(cur, oth);
#pragma unroll
        for (int i = 0; i < 16; ++i) top[c][i] = cur[i];
    }
    float va[16], vb[16];
#pragma unroll
    for (int i = 0; i < 16; ++i) { va[i] = ord2f(top[0][i] & ~0x7Fu); vb[i] = ord2f(top[1][i] & ~0x7Fu); }
#define PEER_CAND(a, b) ((f2ord(va[a] + vb[b]) & ~0xFFu) | (unsigned)(255 - (16 * (a) + (b))))
    unsigned best[16], g1[16], g2[16];
#pragma unroll
    for (int b = 0; b < 16; ++b) best[b] = PEER_CAND(0, b);
#pragma unroll
    for (int b = 0; b < 8; ++b) g1[b] = PEER_CAND(1, b);
#pragma unroll
    for (int b = 0; b < 5; ++b) g1[8 + b] = PEER_CAND(2, b);
#pragma unroll
    for (int b = 0; b < 3; ++b) g1[13 + b] = PEER_CAND(3, b);
    g2[0] = PEER_CAND(3, 3);
#pragma unroll
    for (int b = 0; b < 3; ++b) g2[1 + b] = PEER_CAND(4, b);
#pragma unroll
    for (int a = 5; a < 8; ++a) { g2[4 + 2 * (a - 5)] = PEER_CAND(a, 0); g2[5 + 2 * (a - 5)] = PEER_CAND(a, 1); }
#pragma unroll
    for (int a = 8; a < 14; ++a) g2[10 + (a - 8)] = PEER_CAND(a, 0);
    sort16_desc(g1); merge16_desc(best, g1);
    sort16_desc(g2); merge16_desc(best, g2);
    {
        unsigned x = PEER_CAND(14, 0);
#pragma unroll
        for (int i = 0; i < 16; ++i) ce_desc(best[i], x);
        x = PEER_CAND(15, 0);
#pragma unroll
        for (int i = 0; i < 16; ++i) ce_desc(best[i], x);
    }
#undef PEER_CAND
    LAS unsigned char* tab = lds + hd * 1024 + r * 32;
    if (h == 0) {
#pragma unroll
        for (int i = 0; i < 16; ++i) { tab[i] = (unsigned char)(127 - (top[0][i] & 0x7F)); tab[16 + i] = (unsigned char)(127 - (top[1][i] & 0x7F)); }
    }
    asm volatile("s_waitcnt lgkmcnt(0)" ::: "memory");
    float bv[16], den = 0.f;
    const float b0 = ord2f(best[0] & ~0xFFu);
#pragma unroll
    for (int k = 0; k < 16; ++k) { bv[k] = __expf(ord2f(best[k] & ~0xFFu) - b0); den += bv[k]; }
    const float rden = 1.0f / den;
    if (h == 0) {
#pragma unroll
        for (int k = 0; k < 16; ++k) {
            const int pos = 255 - (int)(best[k] & 0xFF);
            const int e = (int)tab[pos >> 4] * NK + (int)tab[16 + (pos & 15)];
            eid[r * 128 + hd * 16 + k] = (unsigned short)e;
            gw[r * 128 + hd * 16 + k] = bv[k] * rden;
        }
    }
}

__device__ __forceinline__ float dot2bf(unsigned a, unsigned b, float acc) { asm("v_dot2c_f32_bf16 %0, %1, %2" : "+v"(acc) : "v"(a), "v"(b)); return acc; }
__device__ __forceinline__ float dot8(const v4u& a, const v4u& b, float acc) {
    acc = dot2bf(a.x, b.x, acc); acc = dot2bf(a.y, b.y, acc); acc = dot2bf(a.z, b.z, acc); acc = dot2bf(a.w, b.w, acc); return acc;
}
__device__ __forceinline__ void fma8(float (&y)[8], const v4u& v, float a) {
    y[0] += a * __uint_as_float(v.x << 16); y[1] += a * __uint_as_float(v.x & 0xffff0000u);
    y[2] += a * __uint_as_float(v.y << 16); y[3] += a * __uint_as_float(v.y & 0xffff0000u);
    y[4] += a * __uint_as_float(v.z << 16); y[5] += a * __uint_as_float(v.z & 0xffff0000u);
    y[6] += a * __uint_as_float(v.w << 16); y[7] += a * __uint_as_float(v.w & 0xffff0000u);
}

__device__ __forceinline__ void sort512_asc(unsigned (&v)[8], int lane) {
#pragma unroll
    for (int k = 2; k <= 512; k <<= 1) {
#pragma unroll
        for (int j = k >> 1; j > 0; j >>= 1) {
            if (j >= 8) {
                const int lm = j >> 3;
                const bool asc = ((lane & (k >> 3)) == 0) || (k == 512);
                const bool keep_min = asc == ((lane & lm) == 0);
#pragma unroll
                for (int i = 0; i < 8; ++i) {
                    const unsigned o = (unsigned)__shfl_xor((int)v[i], lm);
                    const unsigned mn = v[i] < o ? v[i] : o, mx = v[i] < o ? o : v[i];
                    v[i] = keep_min ? mn : mx;
                }
            } else {
#pragma unroll
                for (int i = 0; i < 8; ++i) {
                    const int i2 = i ^ j;
                    if (i2 > i) {
                        const unsigned mn = v[i] < v[i2] ? v[i] : v[i2], mx = v[i] < v[i2] ? v[i2] : v[i];
                        bool asc;
                        if (k <= 4) asc = ((i & k) == 0); else if (k == 8) asc = ((lane & 1) == 0); else asc = ((lane & (k >> 3)) == 0) || (k == 512);
                        v[i] = asc ? mn : mx; v[i2] = asc ? mx : mn;
                    }
                }
            }
        }
    }
}
__device__ __forceinline__ float sum16(float v) { v += __shfl_xor(v, 8); v += __shfl_xor(v, 4); v += __shfl_xor(v, 2); v += __shfl_xor(v, 1); return v; }

typedef float f32x2 __attribute__((ext_vector_type(2)));
__device__ __forceinline__ void cvt16(const v4u& w, f32x2 (&o)[8]) {
    o[0] = __builtin_amdgcn_cvt_pk_f32_fp8((int)w.x, false); o[1] = __builtin_amdgcn_cvt_pk_f32_fp8((int)w.x, true);
    o[2] = __builtin_amdgcn_cvt_pk_f32_fp8((int)w.y, false); o[3] = __builtin_amdgcn_cvt_pk_f32_fp8((int)w.y, true);
    o[4] = __builtin_amdgcn_cvt_pk_f32_fp8((int)w.z, false); o[5] = __builtin_amdgcn_cvt_pk_f32_fp8((int)w.z, true);
    o[6] = __builtin_amdgcn_cvt_pk_f32_fp8((int)w.w, false); o[7] = __builtin_amdgcn_cvt_pk_f32_fp8((int)w.w, true);
}
__device__ __forceinline__ void peer_apply_wave(const P& p, int l, int row0, const LAS unsigned short* eid4, const LAS float* gw4, LAS unsigned* sk, LAS float* av, int lane) {
    const unsigned char* U = p.u8() + (size_t)l * NK * NK * D;
    const unsigned char* V = p.v8() + (size_t)l * NK * NK * D;
    const int li = lane & 15, tg = lane >> 4, row = row0 + tg;
    {
        unsigned key[8];
        const v4u ev = *(const LAS v4u*)(eid4 + lane * 8);
        const unsigned ee[4] = {ev.x, ev.y, ev.z, ev.w};
#pragma unroll
        for (int i = 0; i < 8; ++i) { const unsigned e = (ee[i >> 1] >> ((i & 1) * 16)) & 0xffffu, n = (unsigned)(lane * 8 + i); key[i] = ((n >> 7) << 23) | (e << 9) | n; }
        sort512_asc(key, lane);
        *(LAS v4u*)(sk + lane * 8) = (v4u){key[0], key[1], key[2], key[3]};
        *(LAS v4u*)(sk + lane * 8 + 4) = (v4u){key[4], key[5], key[6], key[7]};
    }
    asm volatile("s_waitcnt lgkmcnt(0)" ::: "memory");
    const LAS unsigned* skt = sk + tg * 128;
    {
        f32x2 h[4][8];
#pragma unroll
        for (int c = 0; c < 4; ++c) {
            const v4u w0 = *(const v4u*)(p.hb() + (size_t)row * D + 256 * c + 16 * li), w1 = *(const v4u*)(p.hb() + (size_t)row * D + 256 * c + 16 * li + 8);
            const unsigned ww[8] = {w0.x, w0.y, w0.z, w0.w, w1.x, w1.y, w1.z, w1.w};
#pragma unroll
            for (int i = 0; i < 8; ++i) h[c][i] = (f32x2){__uint_as_float(ww[i] << 16), __uint_as_float(ww[i] & 0xffff0000u)};
        }
#pragma unroll 1
        for (int j = 0; j < 128; j += 4) {
            unsigned k[4]; v4u r[4][4];
#pragma unroll
            for (int q = 0; q < 4; ++q) {
                k[q] = skt[j + q];
                const unsigned char* ur = U + (size_t)((k[q] >> 9) & 0x3fffu) * D + 16 * li;
#pragma unroll
                for (int c = 0; c < 4; ++c) r[q][c] = *(const v4u*)(ur + 256 * c);
            }
            float d[4];
#pragma unroll
            for (int q = 0; q < 4; ++q) {
                f32x2 acc = (f32x2){0.f, 0.f};
#pragma unroll
                for (int c = 0; c < 4; ++c) { f32x2 f[8]; cvt16(r[q][c], f);
#pragma unroll
                    for (int i = 0; i < 8; ++i) acc += f[i] * h[c][i]; }
                d[q] = sum16(acc.x + acc.y) * (1.0f / U8_SCALE);
            }
            if (li == 0) {
#pragma unroll
                for (int q = 0; q < 4; ++q) { const int s0 = (int)(k[q] & 511u); av[s0] = gelu_exact(d[q]) * gw4[s0] * (1.0f / V8_SCALE); }
            }
        }
    }
    asm volatile("s_waitcnt lgkmcnt(0)" ::: "memory");
    f32x2 y[4][8];
#pragma unroll
    for (int c = 0; c < 4; ++c)
#pragma unroll
        for (int i = 0; i < 8; ++i) y[c][i] = (f32x2){0.f, 0.f};
#pragma unroll 1
    for (int j = 0; j < 128; j += 4) {
        unsigned k[4]; v4u r[4][4]; float a[4];
#pragma unroll
        for (int q = 0; q < 4; ++q) {
            k[q] = skt[j + q];
            const unsigned char* vr = V + (size_t)((k[q] >> 9) & 0x3fffu) * D + 16 * li;
#pragma unroll
            for (int c = 0; c < 4; ++c) r[q][c] = *(const v4u*)(vr + 256 * c);
            a[q] = av[k[q] & 511u];
        }
#pragma unroll
        for (int q = 0; q < 4; ++q)
#pragma unroll
            for (int c = 0; c < 4; ++c) { f32x2 f[8]; cvt16(r[q][c], f);
#pragma unroll
                for (int i = 0; i < 8; ++i) y[c][i] += f[i] * a[q]; }
    }
    const int ms = modset(row);
    const float* m5 = p.mod() + ((size_t)l * 3 + ms) * (NMOD * D) + 5 * D;
    float* xr = p.xb() + (size_t)row * D;
    float ss = 0.f;
#pragma unroll
    for (int c = 0; c < 4; ++c)
#pragma unroll
        for (int q = 0; q < 4; ++q) {
            const f32x4 xa = *(const f32x4*)(xr + 256 * c + 16 * li + 4 * q), ma = *(const f32x4*)(m5 + 256 * c + 16 * li + 4 * q);
            const float x0 = xa[0] + ma[0] * y[c][2 * q].x, x1 = xa[1] + ma[1] * y[c][2 * q].y, x2 = xa[2] + ma[2] * y[c][2 * q + 1].x, x3 = xa[3] + ma[3] * y[c][2 * q + 1].y;
            y[c][2 * q] = (f32x2){x0, x1}; y[c][2 * q + 1] = (f32x2){x2, x3};
            ss += (x0 * x0 + x1 * x1) + (x2 * x2 + x3 * x3);
        }
    ss = sum16(ss);
    const float rn = rsqrtf(ss * (1.0f / D) + EPS);
    if (l + 1 < DEPTH) {
        const float* g = p.sp_n1g() + (l + 1) * D;
        const float* mn = p.mod() + ((size_t)(l + 1) * 3 + ms) * (NMOD * D);
#pragma unroll
        for (int c = 0; c < 4; ++c) {
            const int k0 = 256 * c + 16 * li;
            unsigned o[8];
#pragma unroll
            for (int q = 0; q < 4; ++q) {
                *(f32x4*)(xr + k0 + 4 * q) = (f32x4){y[c][2 * q].x, y[c][2 * q].y, y[c][2 * q + 1].x, y[c][2 * q + 1].y};
                const f32x4 gg = *(const f32x4*)(g + k0 + 4 * q), sh = *(const f32x4*)(mn + k0 + 4 * q), sc = *(const f32x4*)(mn + D + k0 + 4 * q);
                o[2 * q] = pkbf(y[c][2 * q].x * rn * gg[0] * (1.0f + sc[0]) + sh[0], y[c][2 * q].y * rn * gg[1] * (1.0f + sc[1]) + sh[1]);
                o[2 * q + 1] = pkbf(y[c][2 * q + 1].x * rn * gg[2] * (1.0f + sc[2]) + sh[2], y[c][2 * q + 1].y * rn * gg[3] * (1.0f + sc[3]) + sh[3]);
            }
            *(v4u*)(p.hb() + (size_t)row * D + k0) = (v4u){o[0], o[1], o[2], o[3]};
            *(v4u*)(p.hb() + (size_t)row * D + k0 + 8) = (v4u){o[4], o[5], o[6], o[7]};
        }
    } else {
        const float* g = p.sp_fing();
        float* orow = p.out() + (size_t)row * D;
#pragma unroll
        for (int c = 0; c < 4; ++c)
#pragma unroll
            for (int q = 0; q < 4; ++q) {
                const int k0 = 256 * c + 16 * li + 4 * q;
                const f32x4 gg = *(const f32x4*)(g + k0);
                *(f32x4*)(orow + k0) = (f32x4){y[c][2 * q].x * rn * gg[0], y[c][2 * q].y * rn * gg[1], y[c][2 * q + 1].x * rn * gg[2], y[c][2 * q + 1].y * rn * gg[3]};
            }
    }
}

__device__ __forceinline__ void peer_apply_token64(const P& p, int l, int row, const LAS unsigned short* eid, const LAS float* gw, LAS float* av, int lane) {
    const unsigned char* U = p.u8() + (size_t)l * NK * NK * D + 16 * lane;
    const unsigned char* V = p.v8() + (size_t)l * NK * NK * D + 16 * lane;
    f32x2 h[8];
    {
        const v4u w0 = *(const v4u*)(p.hb() + (size_t)row * D + 16 * lane), w1 = *(const v4u*)(p.hb() + (size_t)row * D + 16 * lane + 8);
        const unsigned ww[8] = {w0.x, w0.y, w0.z, w0.w, w1.x, w1.y, w1.z, w1.w};
#pragma unroll
        for (int i = 0; i < 8; ++i) h[i] = (f32x2){__uint_as_float(ww[i] << 16), __uint_as_float(ww[i] & 0xffff0000u)};
    }
#pragma unroll 1
    for (int j0 = 0; j0 < 128; j0 += 16) {
        v4u r[16];
#pragma unroll
        for (int q = 0; q < 16; ++q) { const int e = __builtin_amdgcn_readfirstlane((int)eid[j0 + q]); r[q] = *(const v4u*)(U + (size_t)e * D); }
        float d[16];
#pragma unroll
        for (int q = 0; q < 16; ++q) { f32x2 f[8]; cvt16(r[q], f); f32x2 acc = f[0] * h[0];
#pragma unroll
            for (int k = 1; k < 8; ++k) acc += f[k] * h[k];
            d[q] = acc.x + acc.y; }
        float w8[8], w4[4], w2[2], w1;
#pragma unroll
        for (int i = 0; i < 8; ++i) { const float keep = (lane & 32) ? d[i + 8] : d[i], send = (lane & 32) ? d[i] : d[i + 8]; w8[i] = keep + __shfl_xor(send, 32); }
#pragma unroll
        for (int i = 0; i < 4; ++i) { const float keep = (lane & 16) ? w8[i + 4] : w8[i], send = (lane & 16) ? w8[i] : w8[i + 4]; w4[i] = keep + __shfl_xor(send, 16); }
#pragma unroll
        for (int i = 0; i < 2; ++i) { const float keep = (lane & 8) ? w4[i + 2] : w4[i], send = (lane & 8) ? w4[i] : w4[i + 2]; w2[i] = keep + __shfl_xor(send, 8); }
        { const float keep = (lane & 4) ? w2[1] : w2[0], send = (lane & 4) ? w2[0] : w2[1]; w1 = keep + __shfl_xor(send, 4); }
        w1 += __shfl_xor(w1, 2); w1 += __shfl_xor(w1, 1);
        const int hit = j0 + ((lane >> 5) & 1) * 8 + ((lane >> 4) & 1) * 4 + ((lane >> 3) & 1) * 2 + ((lane >> 2) & 1);
        if ((lane & 3) == 0) av[hit] = gelu_exact(w1 * (1.0f / U8_SCALE)) * gw[hit] * (1.0f / V8_SCALE);
    }
    asm volatile("s_waitcnt lgkmcnt(0)" ::: "memory");
    f32x2 y[8];
#pragma unroll
    for (int k = 0; k < 8; ++k) y[k] = (f32x2){0.f, 0.f};
#pragma unroll 1
    for (int j0 = 0; j0 < 128; j0 += 16) {
        v4u r[16]; float a[16];
#pragma unroll
        for (int q = 0; q < 16; ++q) { const int e = __builtin_amdgcn_readfirstlane((int)eid[j0 + q]); r[q] = *(const v4u*)(V + (size_t)e * D); a[q] = av[j0 + q]; }
#pragma unroll
        for (int q = 0; q < 16; ++q) { f32x2 f[8]; cvt16(r[q], f);
#pragma unroll
            for (int k = 0; k < 8; ++k) y[k] += f[k] * a[q]; }
    }
    const int ms = modset(row);
    const float* m5 = p.mod() + ((size_t)l * 3 + ms) * (NMOD * D) + 5 * D + 16 * lane;
    float* xr = p.xb() + (size_t)row * D + 16 * lane;
    float xn[16]; float ss = 0.f;
#pragma unroll
    for (int q = 0; q < 4; ++q) {
        const f32x4 xa = *(const f32x4*)(xr + 4 * q), ma = *(const f32x4*)(m5 + 4 * q);
        xn[4 * q] = xa[0] + ma[0] * y[2 * q].x; xn[4 * q + 1] = xa[1] + ma[1] * y[2 * q].y; xn[4 * q + 2] = xa[2] + ma[2] * y[2 * q + 1].x; xn[4 * q + 3] = xa[3] + ma[3] * y[2 * q + 1].y;
        ss += (xn[4 * q] * xn[4 * q] + xn[4 * q + 1] * xn[4 * q + 1]) + (xn[4 * q + 2] * xn[4 * q + 2] + xn[4 * q + 3] * xn[4 * q + 3]);
    }
    ss = wave_sum(ss);
    const float rn = rsqrtf(ss * (1.0f / D) + EPS);
    const float* g = p.sp_n1g() + (l + 1) * D + 16 * lane;
    const float* mn = p.mod() + ((size_t)(l + 1) * 3 + ms) * (NMOD * D) + 16 * lane;
    unsigned o[8];
#pragma unroll
    for (int q = 0; q < 4; ++q) {
        *(f32x4*)(xr + 4 * q) = (f32x4){xn[4 * q], xn[4 * q + 1], xn[4 * q + 2], xn[4 * q + 3]};
        const f32x4 gg = *(const f32x4*)(g + 4 * q), sh = *(const f32x4*)(mn + 4 * q), sc = *(const f32x4*)(mn + D + 4 * q);
        o[2 * q] = pkbf(xn[4 * q] * rn * gg[0] * (1.0f + sc[0]) + sh[0], xn[4 * q + 1] * rn * gg[1] * (1.0f + sc[1]) + sh[1]);
        o[2 * q + 1] = pkbf(xn[4 * q + 2] * rn * gg[2] * (1.0f + sc[2]) + sh[2], xn[4 * q + 3] * rn * gg[3] * (1.0f + sc[3]) + sh[3]);
    }
    *(v4u*)(p.hb() + (size_t)row * D + 16 * lane) = (v4u){o[0], o[1], o[2], o[3]};
    *(v4u*)(p.hb() + (size_t)row * D + 16 * lane + 8) = (v4u){o[4], o[5], o[6], o[7]};
}


template <class EpiF>
__device__ __forceinline__ void ctx_gemm(const bf16_t* A, const bf16_t* Bt, int N, LAS unsigned char* lds, const EpiF& epi) {
    const int tid = opaque_tid(), lane = tid & 63, fr = lane & 15, fq = lane >> 4;
    const int wave = __builtin_amdgcn_readfirstlane(tid >> 6), wr = wave >> 2, wc = wave & 3;
    constexpr int KC = 256, LD = KC * 2 + 16;
    constexpr int ABYTES = 32 * LD, BUF = (32 + 64) * LD;
    const int npc = N / 64, G = gridDim.x;
    for (int piece = blockIdx.x; piece < 16 * npc; piece += G) {
        const int pr = piece / npc, pc = piece - pr * npc;
        const bf16_t* ga[2]; const bf16_t* gb[4]; int la[2], lb[4];
#pragma unroll
        for (int i = 0; i < 2; ++i) { const int id = tid + i * 512, rr = id >> 5, c = id & 31; ga[i] = A + (size_t)(pr * 32 + rr) * D + c * 8; la[i] = rr * LD + c * 16; }
#pragma unroll
        for (int i = 0; i < 4; ++i) { const int id = tid + i * 512, rr = id >> 5, c = id & 31; gb[i] = Bt + (size_t)(pc * 64 + rr) * D + c * 8; lb[i] = ABYTES + rr * LD + c * 16; }
        v4u ra[2], rb[4];
#pragma unroll
        for (int i = 0; i < 2; ++i) ra[i] = *(const v4u*)ga[i];
#pragma unroll
        for (int i = 0; i < 4; ++i) rb[i] = *(const v4u*)gb[i];
        __syncthreads();
#pragma unroll
        for (int i = 0; i < 2; ++i) *(LAS v4u*)(lds + la[i]) = ra[i];
#pragma unroll
        for (int i = 0; i < 4; ++i) *(LAS v4u*)(lds + lb[i]) = rb[i];
        __syncthreads();
        pg8::f32x4 acc = (pg8::f32x4){0.f, 0.f, 0.f, 0.f};
#pragma unroll 1
        for (int c = 0; c < D / KC; ++c) {
            const bool more = c + 1 < D / KC;
            if (more) {
#pragma unroll
                for (int i = 0; i < 2; ++i) ra[i] = *(const v4u*)(ga[i] + (c + 1) * KC);
#pragma unroll
                for (int i = 0; i < 4; ++i) rb[i] = *(const v4u*)(gb[i] + (c + 1) * KC);
            }
            const LAS unsigned char* buf = lds + (c & 1) * BUF;
            const LAS unsigned char* pa = buf + (wr * 16 + fr) * LD + fq * 16;
            const LAS unsigned char* pb = buf + ABYTES + (wc * 16 + fr) * LD + fq * 16;
#pragma unroll
            for (int ks = 0; ks < KC / 32; ++ks) {
                const bf16x8 bf = *(const LAS bf16x8*)(pb + ks * 64), af = *(const LAS bf16x8*)(pa + ks * 64);
                acc = __builtin_amdgcn_mfma_f32_16x16x32_bf16(bf, af, acc, 0, 0, 0);
            }
            if (more) {
                LAS unsigned char* nb = lds + ((c + 1) & 1) * BUF;
#pragma unroll
                for (int i = 0; i < 2; ++i) *(LAS v4u*)(nb + la[i]) = ra[i];
#pragma unroll
                for (int i = 0; i < 4; ++i) *(LAS v4u*)(nb + lb[i]) = rb[i];
            }
            __syncthreads();
        }
        epi(pr * 32 + wr * 16 + fr, pc * 64 + wc * 16 + 4 * fq, acc);
    }
}

#define XB_TMO      128
#define XB_XCNT(j)  (256  + 64 * (j))
#define XB_XSUB(j)  (1280 + 64 * (j))
#define XB_XGEN(j)  (2304 + 64 * (j))
#define XB_TOP      3328
#define XB_TOPGEN   3392
#define XCD_BAR_WORDS 3456
#define XB_UCNT(l)  (3584 + 64 * (l))
#define XB_SPIN_CAP (1u << 18)

__device__ __forceinline__ unsigned xb_ld(unsigned* p)              { return __hip_atomic_load(p, __ATOMIC_RELAXED, __HIP_MEMORY_SCOPE_AGENT); }
__device__ __forceinline__ unsigned xb_add(unsigned* p, unsigned v) { return __hip_atomic_fetch_add(p, v, __ATOMIC_RELAXED, __HIP_MEMORY_SCOPE_AGENT); }
__device__ __forceinline__ unsigned xb_xcc_id() { return (unsigned)__builtin_amdgcn_s_getreg((3 << 11) | 20) & 0xFu; }
#define XB_SPIN(cond, bar) do { unsigned _sp = 0; while (cond) { __builtin_amdgcn_s_sleep(1); \
    if ((++_sp & 255u) == 0u) { if (xb_ld(&(bar)[XB_TMO])) break; if (_sp > XB_SPIN_CAP) { atomicAdd(&(bar)[XB_TMO], 1u); break; } } } } while (0)

struct XcdBarrier {
    unsigned* bar; unsigned x;
    volatile LAS unsigned* st;
};

__device__ __forceinline__ XcdBarrier xcd_barrier_post(unsigned* bar, volatile LAS unsigned* st) {
    XcdBarrier b; b.bar = bar; b.x = xb_xcc_id(); b.st = st;
    if (threadIdx.x == 0) (void)xb_add(&bar[XB_XCNT(b.x)], 1u);
    return b;
}
__device__ __forceinline__ void xcd_barrier_complete(unsigned* bar, unsigned x, unsigned& nloc, unsigned& nx) {
    const unsigned G = gridDim.x * gridDim.y * gridDim.z;
    unsigned sum, cnt, mine, sp = 0u;
    for (;;) {
        sum = 0u; cnt = 0u; mine = 0u;
#pragma unroll
        for (unsigned j = 0; j < 16; ++j) { const unsigned c = xb_ld(&bar[XB_XCNT(j)]); sum += c; cnt += (c > 0u) ? 1u : 0u; mine = (j == x) ? c : mine; }
        if (sum == G) break;
        __builtin_amdgcn_s_sleep(1);
        if ((++sp & 255u) == 0u) { if (xb_ld(&bar[XB_TMO])) break; if (sp > XB_SPIN_CAP) { atomicAdd(&bar[XB_TMO], 1u); break; } }
    }
    nloc = mine > 0u ? mine : 1u; nx = cnt > 0u ? cnt : 1u;
}

__device__ __forceinline__ void xcd_barrier(const XcdBarrier& b) {
    asm volatile("s_waitcnt vmcnt(0)" ::: "memory");
    __syncthreads();
    if (threadIdx.x == 0) {
        unsigned* bar = b.bar;
        __builtin_amdgcn_s_waitcnt(0);
        unsigned nloc = b.st[0], nx = b.st[1];
        if (nloc == 0u) { xcd_barrier_complete(bar, b.x, nloc, nx); b.st[0] = nloc; b.st[1] = nx; }
        const unsigned old = xb_add(&bar[XB_XSUB(b.x)], 1u);
        const unsigned gen = old / nloc;
        if (old + 1u == (gen + 1u) * nloc) {
            __builtin_amdgcn_fence(__ATOMIC_RELEASE, "agent");
            asm volatile("s_waitcnt vmcnt(0)" ::: "memory");
            const unsigned og = xb_add(&bar[XB_TOP], 1u);
            const unsigned tg = og / nx;
            if (og + 1u == (tg + 1u) * nx) xb_add(&bar[XB_TOPGEN], 1u);
            else XB_SPIN(xb_ld(&bar[XB_TOPGEN]) == tg, bar);
            __builtin_amdgcn_fence(__ATOMIC_ACQUIRE, "agent");
            xb_add(&bar[XB_XGEN(b.x)], 1u);
            asm volatile("s_waitcnt vmcnt(0)" ::: "memory");
        } else {
            XB_SPIN(xb_ld(&bar[XB_XGEN(b.x)]) == gen, bar);
            __builtin_amdgcn_fence(__ATOMIC_ACQUIRE, "agent");
            asm volatile("s_waitcnt vmcnt(0)" ::: "memory");
        }
    }
    __syncthreads();
}


__device__ __forceinline__ P fresh(const P& p) { P q = p; asm volatile("" : "+s"(q.ws)); return q; }

__device__ __forceinline__ void convert_expert_tables(const P& p, int l, int ci, int nconv) {
    constexpr unsigned NL = (unsigned)((size_t)NK * NK * D / 4);
    const f32x4* su = (const f32x4*)p.pu() + (size_t)l * NL; const f32x4* sv = (const f32x4*)p.pv() + (size_t)l * NL;
    int* du = (int*)p.u8() + (size_t)l * NL; int* dv = (int*)p.v8() + (size_t)l * NL;
    const unsigned st = (unsigned)nconv * (NWAVES * 64);
    for (unsigned i0 = (unsigned)ci * (NWAVES * 64) + opaque_tid(); i0 < NL; i0 += 8 * st) {
        f32x4 a[8], b[8];
#pragma unroll
        for (int q = 0; q < 8; ++q) { const unsigned i = i0 + q * st; if (i < NL) { a[q] = __builtin_nontemporal_load(su + i); b[q] = __builtin_nontemporal_load(sv + i); } }
#pragma unroll
        for (int q = 0; q < 8; ++q) {
            const unsigned i = i0 + q * st;
            if (i < NL) {
                int wa = __builtin_amdgcn_cvt_pk_fp8_f32(a[q][0] * U8_SCALE, a[q][1] * U8_SCALE, 0, false); wa = __builtin_amdgcn_cvt_pk_fp8_f32(a[q][2] * U8_SCALE, a[q][3] * U8_SCALE, wa, true);
                int wb = __builtin_amdgcn_cvt_pk_fp8_f32(b[q][0] * V8_SCALE, b[q][1] * V8_SCALE, 0, false); wb = __builtin_amdgcn_cvt_pk_fp8_f32(b[q][2] * V8_SCALE, b[q][3] * V8_SCALE, wb, true);
                du[i] = wa; dv[i] = wb;
            }
        }
    }
}

enum { PH_PRO = 0, PH_NORM1 = 1, PH_G1 = 2, PH_ATTN = 3, PH_SSMB = 4, PH_G2 = 5, PH_NORM2 = 6, PH_G3 = 7, PH_PEER = 8, PH_PER_LAYER = 16 };
__host__ __device__ __forceinline__ int phase_id(int l, int k) { return 1 + l * PH_PER_LAYER + (k - 1); }

__global__ void __launch_bounds__(NWAVES * 64, 2) mega(P p, int ph_lo, int ph_hi) {
    extern __shared__ __attribute__((aligned(16))) unsigned char lds[];
    cg::grid_group grid = cg::this_grid();
    const int G = gridDim.x, NGW = G * NWAVES;
    const unsigned NGT = G * NWAVES * 64;
    volatile LAS unsigned* bst = (volatile LAS unsigned*)((LAS unsigned char*)lds + LDS_BYTES - 64);
    if (threadIdx.x < 2) bst[threadIdx.x] = 0u;
    __syncthreads();
    const XcdBarrier bar = xcd_barrier_post(p.ctl(), bst);
#define PHASE_COORDS const int tid = opaque_tid(), lane = tid & 63, wave = __builtin_amdgcn_readfirstlane(tid >> 6), gw = blockIdx.x * NWAVES + wave; const unsigned gtid = blockIdx.x * (NWAVES * 64) + tid; (void)lane; (void)gw; (void)gtid;
#define IN(k) (ph_lo <= (k) && (k) < ph_hi)
#define SYNC_AFTER(k) do { if ((k) + 1 < ph_hi) { if ((k) == PH_PRO) grid.sync(); else xcd_barrier(bar); } } while (0)
    if (IN(PH_PRO)) {
        {
            PHASE_COORDS
            auto convert_tables = [&]() {
            for (unsigned i0 = blockIdx.x * (NWAVES * 64) + opaque_tid(); i0 < (unsigned)((size_t)DEPTH * NK * NK * D / 4); i0 += 4 * NGT) {
                f32x4 a[4], b[4];
#pragma unroll
                for (int q = 0; q < 4; ++q) { const unsigned i = i0 + q * NGT; a[q] = __builtin_nontemporal_load((const f32x4*)p.pu() + i); b[q] = __builtin_nontemporal_load((const f32x4*)p.pv() + i); }
#pragma unroll
                for (int q = 0; q < 4; ++q) {
                    const unsigned i = i0 + q * NGT;
                    int wa = __builtin_amdgcn_cvt_pk_fp8_f32(a[q][0] * U8_SCALE, a[q][1] * U8_SCALE, 0, false); wa = __builtin_amdgcn_cvt_pk_fp8_f32(a[q][2] * U8_SCALE, a[q][3] * U8_SCALE, wa, true);
                    int wb = __builtin_amdgcn_cvt_pk_fp8_f32(b[q][0] * V8_SCALE, b[q][1] * V8_SCALE, 0, false); wb = __builtin_amdgcn_cvt_pk_fp8_f32(b[q][2] * V8_SCALE, b[q][3] * V8_SCALE, wb, true);
                    ((int*)p.u8())[i] = wa; ((int*)p.v8())[i] = wb;
                }
            }
            };
            if (G != 256 && (blockIdx.x & 1)) convert_tables();
            LAS float* scr = (LAS float*)lds + wave * (64 * 33);
            constexpr int I_IN = (D / 64) * (IN_W / 32), I_OUT = (D / 64) * (D / 32), I_Q = (D / 64) * (PH * QD / 32);
            constexpr int PER_L = I_IN + I_OUT + I_Q;
            for (int it = gw; it < DEPTH * PER_L; it += NGW) {
                const int l = it / PER_L; int r = it % PER_L;
                if (r < I_IN) { transpose_item(p.w_in() + (size_t)l * D * IN_W, D, IN_W, p.w_in_t() + (size_t)l * IN_W * D, scr, r, lane); continue; } r -= I_IN;
                if (r < I_OUT) { transpose_item(p.w_out() + (size_t)l * D * D, D, D, p.w_out_t() + (size_t)l * D * D, scr, r, lane); continue; } r -= I_OUT;
                transpose_item(p.wq() + (size_t)l * D * PH * QD, D, PH * QD, p.wq_t() + (size_t)l * PH * QD * D, scr, r, lane);
            }
            for (int it = gw; it < DEPTH * 32 + DEPTH * 4 * 2; it += NGW) {
                if (it < DEPTH * 32) { const int l = it / 32; transpose_item(p.w_glu() + (size_t)l * SSM_W * SSM_W, SSM_W, SSM_W, p.wglu_t() + (size_t)l * SSM_W * SSM_W, scr, it % 32, lane); }
                else { const int r = it - DEPTH * 32, mtx = r >> 1; transpose_item(p.pool_w() + (size_t)mtx * 64 * 64, 64, 64, p.poolw_t() + (size_t)mtx * 64 * 64, scr, r & 1, lane); }
            }
            __syncthreads();
            ssm_tables(p, (LAS unsigned char*)lds);
            {
                LAS float* sl = (LAS float*)lds + NWAVES * 64 * 33;
                __syncthreads();
                for (int i = tid; i < 3 * D; i += NWAVES * 64) { const float cv = i < 2 * D ? p.c()[i] : p.c_ctx()[i - 2 * D]; sl[i] = cv / (1.0f + __expf(-cv)); }
                __syncthreads();
                for (int it = gw; it < DEPTH * (NMOD * D / 16); it += NGW) {
                    const int l = it / (NMOD * D / 16), j = (it % (NMOD * D / 16)) * 16 + (lane & 15), k0 = (lane >> 4) * 256;
                    const float* w = p.w_mod() + (size_t)l * D * (NMOD * D) + (size_t)k0 * (NMOD * D) + j;
                    float a0 = 0.f, a1 = 0.f, a2 = 0.f;
#pragma unroll 16
                    for (int k = 0; k < 256; ++k) {
                        const float wv = w[(size_t)k * (NMOD * D)];
                        a0 += sl[k0 + k] * wv; a1 += sl[D + k0 + k] * wv; a2 += sl[2 * D + k0 + k] * wv;
                    }
                    a0 += __shfl_xor(a0, 16); a1 += __shfl_xor(a1, 16); a2 += __shfl_xor(a2, 16);
                    a0 += __shfl_xor(a0, 32); a1 += __shfl_xor(a1, 32); a2 += __shfl_xor(a2, 32);
                    if (lane < 16) {
                        const float bb = p.b_mod()[(size_t)l * NMOD * D + j];
                        float* mo = p.mod() + (size_t)l * 3 * NMOD * D + j;
                        mo[0] = a0 + bb; mo[NMOD * D] = a1 + bb; mo[2 * NMOD * D] = a2 + bb;
                    }
                }
                __syncthreads();
            }
            for (unsigned i = blockIdx.x * (NWAVES * 64) + opaque_tid(); i < (unsigned)(DEPTH * D); i += NGT) {
                p.sp_n1g()[i] = p.norm1_g()[i]; p.sp_n2g()[i] = p.norm2_g()[i];
                if (i < (unsigned)D) p.sp_fing()[i] = p.final_g()[i];
                if (i < (unsigned)(DEPTH * VD)) p.sp_subln()[i] = p.subln_g()[i];
                if (i < (unsigned)(DEPTH * SSM_W)) { p.sp_ssmd()[i] = p.ssm_d()[i]; p.sp_poolsc()[i] = p.pool_scale()[i]; }
            }
            for (unsigned i = blockIdx.x * (NWAVES * 64) + opaque_tid(); i < (size_t)64 * 64; i += NGT) {
                float lre, lim, step, cr, ci; ssm_zoh(p, (int)(i >> 6), (int)(i & 63), lre, lim, step, cr, ci);
                float ar, ai; ssm_apow(lre, lim, step, 64.0f, ar, ai);
                p.sp_a64()[i * 2] = ar; p.sp_a64()[i * 2 + 1] = ai;
            }
            if (gw < DEPTH) {
                const int l = gw;
                const float s1 = wave_sum(p.lam_q1()[l * HD + lane] * p.lam_k1()[l * HD + lane]);
                const float s2 = wave_sum(p.lam_q2()[l * HD + lane] * p.lam_k2()[l * HD + lane]);
                const float lam_init = 0.8f - 0.6f * expf(-0.3f * (float)l);
                if (lane == 0) { p.sp_lam()[l * 2] = expf(s1) - expf(s2) + lam_init; p.sp_lam()[l * 2 + 1] = lam_init; }
            }
            for (unsigned i = blockIdx.x * (NWAVES * 64) + opaque_tid(); i < (unsigned)((size_t)DEPTH * PH * 2 * NK * KD / 4); i += NGT) {
                const f32x4 v = ((const f32x4*)p.keys())[i];
                v2u w; w.x = pkbf(v[0], v[1]); w.y = pkbf(v[2], v[3]);
                const unsigned d4 = i & 31u, nk = (i >> 5) & 127u, hc = i >> 12;
                const unsigned dd = d4 * 4, ks = dd >> 4, hh = (dd >> 3) & 1u, e = dd & 7u, nb = nk >> 5, r = nk & 31u;
                const unsigned o = (((hc * 4 + nb) * 8 + ks) * 64 + hh * 32 + r) * 8 + e;
                *(v2u*)(p.keysb() + o) = w;
            }
            if (G != 256 && !(blockIdx.x & 1)) convert_tables();
            for (unsigned i = blockIdx.x * (NWAVES * 64) + opaque_tid(); i < (size_t)SEQ * 32; i += NGT) {
                const int ii = (int)(i & 15), a = (int)(i >> 4) & 1, t = (int)(i >> 5);
                const int pos = a == 0 ? t / GRIDW : t % GRIDW;
                const float inv = 1.0f / powf(10000.0f, (float)ii / 16.0f);
                const float ang = (float)pos * inv;
                p.ropet()[i * 2] = cosf(ang); p.ropet()[i * 2 + 1] = sinf(ang);
            }
        }
        SYNC_AFTER(PH_PRO);
    }
    for (int l = 0; l < DEPTH; ++l) {
        {
            const float* modl = p.mod() + (size_t)l * 3 * NMOD * D;
            if (l == 0 && IN(phase_id(l, PH_NORM1))) {
                PHASE_COORDS const P p_ = fresh(p); const float* modl_ = p_.mod() + (size_t)l * 3 * NMOD * D; (void)modl_;
                const float* xin_ = p_.x(); const float* cin_ = p_.ctx();
                normmod_rows([&](int row) { return row < RL ? xin_ + (size_t)row * D : cin_ + (size_t)(row - RL) * D; },
                             p_.sp_n1g() + l * D, modl_, 0, 1, p_.hb(), R, gw, NGW, lane);
                SYNC_AFTER(phase_id(l, PH_NORM1));
            }
            if (IN(phase_id(l, PH_G1))) {
                PHASE_COORDS const P p_ = fresh(p); const float* modl_ = p_.mod() + (size_t)l * 3 * NMOD * D; (void)modl_;
                pg8::Gemm g{p_.hb(), p_.w_in_t() + (size_t)l * IN_W * D, R, IN_W, D};
                unsigned* ucnt = p_.ctl() + XB_UCNT(l);
                pg8::InProjOrder S{G, (int)blockIdx.x, ucnt};
                EpiInProj E{p_.qb(), p_.ropet()};
                pg8::gemm_phase<EpiInProj, pg8::InProjOrder, true, true>((PG8_LAS unsigned char*)lds, g, S, E);
                {
                    const int nss = pg8::InProjOrder::n_ssm_wg(G), i0 = nss ? (int)blockIdx.x - (G - nss) : (int)blockIdx.x, st = nss ? 64 : G;
                    if (i0 >= 0 && i0 < 64) {
                        if (opaque_tid() == 0) {
                            XB_SPIN(xb_ld(ucnt) < 66u * NWAVES, p_.ctl());
                            __builtin_amdgcn_fence(__ATOMIC_ACQUIRE, "agent");
                            asm volatile("s_waitcnt vmcnt(0)" ::: "memory");
                        }
                        __syncthreads();
                        for (int i = i0; i < 64; i += st) ssm_a_item(p_, l, i >> 5, (i >> 4) & 1, i & 15, (LAS unsigned char*)lds);
                    }
                }
                if (G == 256) {
                    const int x = (int)blockIdx.x & 7, s_ = (int)blockIdx.x >> 3;
                    const int ci = x < 2 ? (s_ >= 16 && s_ < 24 ? x * 8 + (s_ - 16) : -1) : (s_ >= 8 && s_ < 24 ? 16 + (x - 2) * 16 + (s_ - 8) : -1);
                    if (ci >= 0) convert_expert_tables(p_, l, ci, 112);
                }
                SYNC_AFTER(phase_id(l, PH_G1));
            }
            if (IN(phase_id(l, PH_ATTN))) {
                PHASE_COORDS const P p_ = fresh(p); const float* modl_ = p_.mod() + (size_t)l * 3 * NMOD * D; (void)modl_;
                attn_phase(p_, l, (LAS unsigned char*)lds, l + 1 < DEPTH);
                for (int i = blockIdx.x; i < 256; i += G) { const int b = i >> 7, c = i & 127; ssm_b_unit(p_, l, b * SEQ + 64 * c, b * SEQ, SEQ, (LAS unsigned char*)lds); }
                if (l + 1 < DEPTH) {
                    for (int ci = (int)((blockIdx.x + (unsigned)G - 16u % (unsigned)G) % (unsigned)G); ci < 8; ci += G) { const int b = ci >> 2, c = ci & 3; ssm_b_unit(p_, l, RL + b * CTX + 64 * c, RL + b * CTX, CTX, (LAS unsigned char*)lds); }
                }
                SYNC_AFTER(phase_id(l, PH_ATTN));
            }
            const int MR = l + 1 < DEPTH ? R : RL;
            if (IN(phase_id(l, PH_G2))) {
                PHASE_COORDS const P p_ = fresh(p); const float* modl_ = p_.mod() + (size_t)l * 3 * NMOD * D; (void)modl_;
                pg8::Gemm g{p_.mixb(), p_.w_out_t() + (size_t)l * D * D, RL, D, D};
                pg8::StaticOrder S; S.init(RL, D, G, (int)blockIdx.x);
                EpiResid E{p_.xb(), modl_, l == 0 ? p_.x() : p_.xb(), l == 0 ? p_.ctx() : p_.xb() + (size_t)RL * D};
                pg8::gemm_phase<EpiResid, pg8::StaticOrder, true, true>((PG8_LAS unsigned char*)lds, g, S, E);
                if (MR > RL) {
                    const float* gate = modl_ + (size_t)2 * (NMOD * D) + 2 * D;
                    const float* xs = l == 0 ? p_.ctx() : p_.xb() + (size_t)RL * D;
                    float* xo = p_.xb() + (size_t)RL * D;
                    ctx_gemm(p_.mixb() + (size_t)RL * D, p_.w_out_t() + (size_t)l * D * D, D, (LAS unsigned char*)lds,
                             [&](int row, int col, const pg8::f32x4& a) {
                                 const pg8::f32x4 gv = *(const pg8::f32x4*)(gate + col), xv = *(const pg8::f32x4*)(xs + (size_t)row * D + col);
                                 *(pg8::f32x4*)(xo + (size_t)row * D + col) = xv + gv * a;
                             });
                }
                SYNC_AFTER(phase_id(l, PH_G2));
            }
            if (IN(phase_id(l, PH_NORM2))) {
                PHASE_COORDS const P p_ = fresh(p); const float* modl_ = p_.mod() + (size_t)l * 3 * NMOD * D; (void)modl_;
                const float* xb_ = p_.xb();
                {
                    pg8::StaticOrder SO; SO.init(RL, D, G, (int)blockIdx.x);
                    pg8::Unit u;
                    for (int i = 0; SO.next(i, u); ++i) {
                        const int r0 = u.pm * 256 + u.pn * 64;
                        normmod_rows([&](int row) { return xb_ + (size_t)row * D; }, p_.sp_n2g() + l * D, modl_, 3, 4, p_.hb(), r0 + 64, r0 + wave, NWAVES, lane);
                    }
                    if (MR > RL) {
                        for (int piece = blockIdx.x; piece < 256; piece += G) {
                            const int pr = piece >> 4, pc = piece & 15;
                            const int r0 = RL + pr * 32 + pc * 2;
                            normmod_rows([&](int row) { return xb_ + (size_t)row * D; }, p_.sp_n2g() + l * D, modl_, 3, 4, p_.hb(), r0 + 2, r0 + wave, NWAVES, lane);
                        }
                    }
                }
                SYNC_AFTER(phase_id(l, PH_NORM2));
            }
            if (IN(phase_id(l, PH_G3))) {
                PHASE_COORDS const P p_ = fresh(p); const float* modl_ = p_.mod() + (size_t)l * 3 * NMOD * D; (void)modl_;
                pg8::Gemm g{p_.hb(), p_.wq_t() + (size_t)l * PH * QD * D, RL, PH * QD, D};
                pg8::StaticOrder S; S.init(RL, PH * QD, G, (int)blockIdx.x);
                pg8::EpiBf16<0> E{p_.qpb(), PH * QD, nullptr, 0, 0, 1.f};
                pg8::gemm_phase<pg8::EpiBf16<0>, pg8::StaticOrder, true, true>((PG8_LAS unsigned char*)lds, g, S, E);
                if (MR > RL) {
                    bf16_t* qo = p_.qpb() + (size_t)RL * (PH * QD);
                    ctx_gemm(p_.hb() + (size_t)RL * D, p_.wq_t() + (size_t)l * PH * QD * D, PH * QD, (LAS unsigned char*)lds,
                             [&](int row, int col, const pg8::f32x4& a) {
                                 v2u w; w.x = pg8::cvt_pk_bf16(a[0], a[1]); w.y = pg8::cvt_pk_bf16(a[2], a[3]);
                                 *(v2u*)(qo + (size_t)row * (PH * QD) + col) = w;
                             });
                }
                SYNC_AFTER(phase_id(l, PH_G3));
            }
            if (IN(phase_id(l, PH_PEER))) {
                PHASE_COORDS const P p_ = fresh(p); const float* modl_ = p_.mod() + (size_t)l * 3 * NMOD * D; (void)modl_;
                LAS unsigned char* L = (LAS unsigned char*)lds;
                LAS unsigned short* eid = (LAS unsigned short*)(L + 8192);
                LAS float* gwt = (LAS float*)(L + 16384);
                for (int tile = blockIdx.x; tile < RL / 32; tile += G) {
                    peer_score_tile(p_, l, tile * 32, MR, L, eid, gwt);
                    __syncthreads();
                    {
                        const int tid2 = opaque_tid(), lane2 = tid2 & 63, wave2 = __builtin_amdgcn_readfirstlane(tid2 >> 6);
                        LAS unsigned* sk = (LAS unsigned*)(L + 32768) + wave2 * 512;
                        LAS float* av = (LAS float*)(L + 49152) + wave2 * 512;
                        peer_apply_wave(p_, l, tile * 32 + wave2 * 4, eid + wave2 * 512, gwt + wave2 * 512, sk, av, lane2);
                    }
                    __syncthreads();
                }
                if (MR > RL) {
                    const int cpw = (R - RL + G - 1) / G, row0 = RL + blockIdx.x * cpw;
                    if (row0 < R) {
                        const int rend = row0 + cpw < R ? row0 + cpw : R;
                        peer_score_tile(p_, l, row0, rend, L, eid, gwt);
                        __syncthreads();
                        {
                            const int tid2 = opaque_tid(), lane2 = tid2 & 63, wave2 = __builtin_amdgcn_readfirstlane(tid2 >> 6);
                            LAS float* av = (LAS float*)(L + 49152) + wave2 * 512;
                            for (int t = wave2; row0 + t < rend; t += NWAVES) peer_apply_token64(p_, l, row0 + t, eid + t * 128, gwt + t * 128, av, lane2);
                        }
                        __syncthreads();
                    }
                }
                SYNC_AFTER(phase_id(l, PH_PEER));
            }
        }
    }
#undef IN
#undef SYNC_AFTER
#undef PHASE_COORDS
}

static void launch_mega(const P& p, int lo, int hi, int grid, hipStream_t stream) {
    P pp = p; int a = lo, b = hi;
    void* args[] = {(void*)&pp, (void*)&a, (void*)&b};
    hipError_t e = hipLaunchCooperativeKernel((const void*)mega, dim3(grid), dim3(NWAVES * 64), args, LDS_BYTES, stream);
    if (e != hipSuccess) fprintf(stderr, "cooperative launch failed: %s (grid %d)\n", hipGetErrorString(e), grid);
}

extern "C" void kernel_launch(void* const* d_in, const int* in_sizes, int n_in, void* d_out, int out_size, void* d_ws, size_t ws_size, hipStream_t stream) {
    static int grid = 0;
    if (grid == 0) {
        int dev = 0, cus = 0, per_cu = 0;
        (void)hipGetDevice(&dev);
        (void)hipDeviceGetAttribute(&cus, hipDeviceAttributeMultiprocessorCount, dev);
        (void)hipFuncSetAttribute((const void*)mega, hipFuncAttributeMaxDynamicSharedMemorySize, LDS_BYTES);
        (void)hipOccupancyMaxActiveBlocksPerMultiprocessor(&per_cu, (const void*)mega, NWAVES * 64, LDS_BYTES);
        if (per_cu < 1) { fprintf(stderr, "occupancy query says %d blocks/CU\n", per_cu); per_cu = 1; }
        grid = cus * per_cu;
        fprintf(stderr, "grid = %d (cus %d x %d), ws_size = %zu\n", grid, cus, per_cu, ws_size);
    }
    P p{};
    for (int i = 0; i < 31; ++i) p.in[i] = (const float*)d_in[i];
    p.out_ = (float*)d_out; p.ws = (unsigned char*)d_ws;
    if (WS_TOTAL > ws_size || n_in != 31) { fprintf(stderr, "workspace too small or bad inputs: need %zu have %zu, n_in %d\n", (size_t)WS_TOTAL, ws_size, n_in); return; }

    (void)hipMemsetAsync((char*)d_ws + OFF_ctl, 0, CTL_BYTES, stream);
    launch_mega(p, PH_PRO, phase_id(DEPTH - 1, PH_PEER) + 1, grid, stream);
}
```
